# Optimizing an MI355X kernel written in HIP

```python
import math
import jax, jax.numpy as jnp
from jax import lax
import numpy as np

D_MODEL = 1024
BATCH = 8
SEQ = 8192
DEPTH = 4

N_A = DEPTH // 2
N_B = DEPTH - N_A
MIX_W = D_MODEL
MEM_W = D_MODEL
IN_W = MIX_W + MEM_W
POOL_WINDOWS = (2, 4, 8, 16)
N_POOL = len(POOL_WINDOWS)
POOL_C = MIX_W // N_POOL
DIFF_HEADS = 4
DIFF_HD = 128
DIFF_VD = 2 * DIFF_HD
Q_BLOCK = 128
SUBLN_EPS = 1e-5
ROPE_THETA = 500000.0
ROT_DIM = DIFF_HD // 4
N_MEM = 256
MEM_HEADS = 4
MEM_HD = MEM_W // MEM_HEADS
D_FF = ((8 * D_MODEL // 3 + 255) // 256) * 256
NORM_EPS = 1e-6

kernel_name = "yoco_pool_diffattn_memory_block"


def rmsnorm(x, g, eps=NORM_EPS):
    xf = x.astype(jnp.float32)
    y = xf * lax.rsqrt(jnp.mean(xf * xf, axis=-1, keepdims=True) + eps)
    return (y * g.astype(jnp.float32)).astype(x.dtype)


def rope_tables(seq_len):
    pos = jnp.arange(seq_len, dtype=jnp.float32)
    inv_freq = jnp.power(jnp.float32(ROPE_THETA), -jnp.arange(0, ROT_DIM, 2, dtype=jnp.float32) / ROT_DIM)
    ang = pos[:, None] * inv_freq[None, :]
    ang = jnp.concatenate([ang, ang], axis=-1)
    return jnp.cos(ang), jnp.sin(ang)


def apply_partial_rope(t, cos, sin):
    shp = (1, t.shape[1]) + (1,) * (t.ndim - 3) + (ROT_DIM,)
    c = cos.reshape(shp)
    s = sin.reshape(shp)
    tr = t[..., :ROT_DIM].astype(jnp.float32)
    half = ROT_DIM // 2
    rot = jnp.concatenate([-tr[..., half:], tr[..., :half]], axis=-1)
    return jnp.concatenate([(tr * c + rot * s).astype(t.dtype), t[..., ROT_DIM:]], axis=-1)


def multi_scale_pool(u, w_pool, scale):
    b, s, _ = u.shape
    uf = u.astype(jnp.float32).reshape(b, s, N_POOL, POOL_C)
    csum = lax.cumsum(uf, axis=1)
    t = jnp.arange(s)
    outs = []
    for g, w in enumerate(POOL_WINDOWS):
        cg = csum[:, :, g]
        lagged = jnp.pad(cg, ((0, 0), (w, 0), (0, 0)))[:, :s]
        cnt = jnp.minimum(t + 1, w).astype(jnp.float32)[None, :, None]
        outs.append((cg - lagged) / cnt - uf[:, :, g])
    pooled = jnp.stack(outs, axis=2).astype(u.dtype)
    y = jnp.einsum('bsgc,gce->bsge', pooled, w_pool).reshape(b, s, MIX_W)
    return y * scale


def shared_kv(h, g_kv, w_kv, cos, sin):
    b, s, _ = h.shape
    kv = rmsnorm(h, g_kv) @ w_kv
    k = kv[..., :DIFF_HEADS * 2 * DIFF_HD].reshape(b, s, DIFF_HEADS, 2, DIFF_HD)
    v = kv[..., DIFF_HEADS * 2 * DIFF_HD:].reshape(b, s, DIFF_HEADS, DIFF_VD)
    return apply_partial_rope(k, cos, sin), v


def diff_attention(zq, k, v, lq1, lk1, lq2, lk2, g_sub, lambda_init, cos, sin):
    b, s, _ = zq.shape
    q = apply_partial_rope(zq.reshape(b, s, DIFF_HEADS, 2, DIFF_HD), cos, sin)
    lam = (jnp.exp(jnp.sum(lq1.astype(jnp.float32) * lk1.astype(jnp.float32)))
           - jnp.exp(jnp.sum(lq2.astype(jnp.float32) * lk2.astype(jnp.float32)))
           + lambda_init)
    scale = DIFF_HD ** -0.5
    nblk = s // Q_BLOCK
    qb = q.reshape(b, nblk, Q_BLOCK, DIFF_HEADS, 2, DIFF_HD).transpose(1, 0, 2, 3, 4, 5)
    kpos = jnp.arange(s)

    def one_block(args):
        qi, bi = args
        qpos = bi * Q_BLOCK + jnp.arange(Q_BLOCK)
        sc = jnp.einsum('bqhcd,bkhcd->bhcqk', qi, k).astype(jnp.float32) * scale
        mask = kpos[None, :] <= qpos[:, None]
        sc = jnp.where(mask[None, None, None], sc, -jnp.inf)
        p = jax.nn.softmax(sc, axis=-1)
        a = p[:, :, 0] - lam * p[:, :, 1]
        return jnp.einsum('bhqk,bkhe->bqhe', a.astype(v.dtype), v)

    o = lax.map(one_block, (qb, jnp.arange(nblk)))
    o = o.transpose(1, 0, 2, 3, 4).reshape(b, s, DIFF_HEADS, DIFF_VD)
    o = rmsnorm(o, g_sub, SUBLN_EPS) * (1.0 - lambda_init)
    return o.reshape(b, s, MIX_W)


def memory_attention(zq, mem, g_mem, w_mem_kv):
    b, s, _ = zq.shape
    q = zq.reshape(b, s, MEM_HEADS, MEM_HD)
    kv = rmsnorm(mem, g_mem) @ w_mem_kv
    m = mem.shape[1]
    km = kv[..., :MEM_W].reshape(b, m, MEM_HEADS, MEM_HD)
    vm = kv[..., MEM_W:].reshape(b, m, MEM_HEADS, MEM_HD)
    sc = jnp.einsum('bshd,bmhd->bhsm', q, km).astype(jnp.float32) * (MEM_HD ** -0.5)
    p = jax.nn.softmax(sc, axis=-1)
    o = jnp.einsum('bhsm,bmhd->bshd', p.astype(vm.dtype), vm)
    return o.reshape(b, s, MEM_W)


def swiglu(x, w_gate, w_up, w_down):
    return (jax.nn.silu(x @ w_gate) * (x @ w_up)) @ w_down


def setup_inputs(seed: int = 0) -> dict:
    key = jax.random.key(seed)
    ks = jax.random.split(key, 24)
    f32 = jnp.float32

    def nrm(k, shape, fan_in):
        return jax.random.normal(k, shape, f32) * (fan_in ** -0.5)

    def gain(k, shape):
        return 1.0 + 0.02 * jax.random.normal(k, shape, f32)

    return {
        "x": jax.random.normal(ks[0], (BATCH, SEQ, D_MODEL), f32),
        "mem": jax.random.normal(ks[1], (BATCH, N_MEM, D_MODEL), f32),
        "w_in": nrm(ks[2], (DEPTH, D_MODEL, IN_W), D_MODEL),
        "w_out": nrm(ks[3], (DEPTH, IN_W, D_MODEL), IN_W),
        "g_mix": gain(ks[4], (DEPTH, D_MODEL)),
        "g_ffn": gain(ks[5], (DEPTH, D_MODEL)),
        "w_gate": nrm(ks[6], (DEPTH, D_MODEL, D_FF), D_MODEL),
        "w_up": nrm(ks[7], (DEPTH, D_MODEL, D_FF), D_MODEL),
        "w_down": nrm(ks[8], (DEPTH, D_FF, D_MODEL), D_FF),
        "g_mem": gain(ks[9], (DEPTH, D_MODEL)),
        "w_mem_kv": nrm(ks[10], (DEPTH, D_MODEL, 2 * MEM_W), D_MODEL),
        "pool_w": nrm(ks[11], (N_A, N_POOL, POOL_C, POOL_C), POOL_C),
        "pool_scale": 1.0 + 0.1 * jax.random.normal(ks[12], (N_A, MIX_W), f32),
        "g_kv": gain(ks[13], (D_MODEL,)),
        "w_kv": nrm(ks[14], (D_MODEL, DIFF_HEADS * 2 * DIFF_HD + DIFF_HEADS * DIFF_VD), D_MODEL),
        "lam_q1": 0.1 * jax.random.normal(ks[15], (N_B, DIFF_HD), f32),
        "lam_k1": 0.1 * jax.random.normal(ks[16], (N_B, DIFF_HD), f32),
        "lam_q2": 0.1 * jax.random.normal(ks[17], (N_B, DIFF_HD), f32),
        "lam_k2": 0.1 * jax.random.normal(ks[18], (N_B, DIFF_HD), f32),
        "g_subln": gain(ks[19], (N_B, DIFF_VD)),
        "g_final": gain(ks[20], (D_MODEL,)),
    }


def reference(x, mem, w_in, w_out, g_mix, g_ffn, w_gate, w_up, w_down, g_mem, w_mem_kv,
              pool_w, pool_scale, g_kv, w_kv, lam_q1, lam_k1, lam_q2, lam_k2, g_subln, g_final):
    cos, sin = rope_tables(x.shape[1])
    h = x
    k_sh = None
    v_sh = None
    for i in range(DEPTH):
        z = rmsnorm(h, g_mix[i]) @ w_in[i]
        z_mix = z[..., :MIX_W]
        z_memq = z[..., MIX_W:]
        if i < N_A:
            mix = multi_scale_pool(z_mix, pool_w[i], pool_scale[i])
        else:
            j = i - N_A
            lambda_init = 0.8 - 0.6 * math.exp(-0.3 * i)
            mix = diff_attention(z_mix, k_sh, v_sh, lam_q1[j], lam_k1[j], lam_q2[j], lam_k2[j],
                                 g_subln[j], lambda_init, cos, sin)
        mem_out = memory_attention(z_memq, mem, g_mem[i], w_mem_kv[i])
        h = h + jnp.concatenate([mix, mem_out], axis=-1) @ w_out[i]
        h = h + swiglu(rmsnorm(h, g_ffn[i]), w_gate[i], w_up[i], w_down[i])
        if i == N_A - 1:
            k_sh, v_sh = shared_kv(h, g_kv, w_kv, cos, sin)
    return rmsnorm(h, g_final)
```

```cpp
#include <hip/hip_runtime.h>
#include <hip/hip_cooperative_groups.h>
#include <cstdio>
#include <cstdint>
#include <cmath>
namespace cg = cooperative_groups;

#define LAS __attribute__((address_space(3)))
typedef unsigned short bf16_t;
typedef short bf16x8 __attribute__((ext_vector_type(8)));
typedef short s16x4 __attribute__((ext_vector_type(4)));
typedef float f32x4 __attribute__((ext_vector_type(4)));
typedef float f32x16 __attribute__((ext_vector_type(16)));
typedef unsigned u32x4 __attribute__((ext_vector_type(4)));
typedef unsigned u32x2 __attribute__((ext_vector_type(2)));
typedef float f32x2 __attribute__((ext_vector_type(2)));
template <class A, class Bt> struct same_t { static constexpr bool v = false; };
template <class A> struct same_t<A, A> { static constexpr bool v = true; };

constexpr int DM = 1024, NB = 8, SEQ = 8192, MTOK = NB * SEQ, INW = 2048, DFF = 2816, NMEM = 256, MROWS = NB * NMEM;
constexpr int HALF_M = MTOK / 2;
constexpr size_t MiB = 1u << 20;
constexpr int LDCAT = INW + 64;
constexpr size_t WS_CAT = 0, WS_Z = 264 * MiB, WS_KV = 520 * MiB, WS_P = 776 * MiB, WS_OSCR = 904 * MiB;
constexpr size_t WS_WIN = 936 * MiB, WS_WOUT = 940 * MiB, WS_WGU = 945 * MiB, WS_WDN = 956 * MiB, WS_WMKV = 962 * MiB, WS_WPOOL = 966 * MiB, WS_WKV = 967 * MiB;
constexpr size_t WS_MEMN = 971 * MiB, WS_KM = 975 * MiB, WS_VT = 979 * MiB, WS_ROPE = 983 * MiB, WS_CTL = 984 * MiB, WS_SSQ = 985 * MiB, WS_END = 994 * MiB;
constexpr int LDS_STATS = 131072, LDS_MISC = 131072 + 16384, LDS_BYTES = LDS_MISC + 64;
constexpr int NTHREADS = 512, NWAVES = 8;

__device__ __forceinline__ unsigned cvt_pk_bf16(float lo, float hi) { unsigned r; asm volatile("v_cvt_pk_bf16_f32 %0, %1, %2" : "=v"(r) : "v"(lo), "v"(hi)); return r; }
__device__ __forceinline__ float bf_lo(unsigned w) { return __uint_as_float(w << 16); }
__device__ __forceinline__ float bf_hi(unsigned w) { return __uint_as_float(w & 0xffff0000u); }
template <int X> __device__ __forceinline__ float swz(float v) { return __int_as_float(__builtin_amdgcn_ds_swizzle(__float_as_int(v), (X << 10) | 0x1f)); }
__device__ __forceinline__ float sum32(float v) { auto rr = __builtin_amdgcn_permlane32_swap(__float_as_uint(v), __float_as_uint(v), false, false); return __uint_as_float(rr[0]) + __uint_as_float(rr[1]); }
__device__ __forceinline__ float max32(float v) { auto rr = __builtin_amdgcn_permlane32_swap(__float_as_uint(v), __float_as_uint(v), false, false); return fmaxf(__uint_as_float(rr[0]), __uint_as_float(rr[1])); }
__device__ __forceinline__ float other32(float v, bool upper) { auto rr = __builtin_amdgcn_permlane32_swap(__float_as_uint(v), __float_as_uint(v), false, false); return __uint_as_float(upper ? rr[0] : rr[1]); }
__device__ __forceinline__ float wave_sum(float v) { v += swz<1>(v); v += swz<2>(v); v += swz<4>(v); v += swz<8>(v); v += swz<16>(v); return sum32(v); }

namespace pg8 {
constexpr int BM = 256, BK = 64, HALF = 128, HTB = HALF * BK * 2, STAGE_BYTES = 8 * HTB, NXCD = 8, WGM = 8;
__host__ __device__ __forceinline__ int lds_byte(int r, int c) { const int st = (r >> 4) * 2 + (c >> 5), rr = r & 15, cc = c & 31, ob = rr * 64 + cc * 2; return st * 1024 + (ob ^ (((ob >> 9) & 1) << 5)); }
__host__ __device__ __forceinline__ void stage_rc(int b, int& R, int& C) { const int st = b / 1024, sb = b % 1024, swz = sb ^ (((sb >> 9) & 1) << 5); R = (st >> 1) * 16 + swz / 64; C = (st & 1) * 32 + (swz % 64) / 2; }
__host__ __device__ __forceinline__ int perm32(int rho) { const int n = rho >> 4, i = rho & 15; return 8 * (i >> 2) + 4 * n + (i & 3); }

struct Unit { int pm, pn, b, h; };
enum { EPI_BF16 = 0, EPI_RES = 1, EPI_SWIGLU = 2, EPI_SOFTMAX = 3 };
struct GemmDesc {
    const char* A; const char* B;
    int lda, ldb, K;
    int rev;
    int sched, nM, nN, cid, G;
    long a_h, b_b, b_h;
    int epi;
    void* O; int ldc; int col_off, col_h;
    int rope_limit; const float* cosT; const float* sinT; const float* colscale;
    const float* base;
    bf16_t* hb; float* ssq_out;
    const float* ssq_in;
};
__device__ __forceinline__ bool unit_next(const GemmDesc& d, int i, Unit& u) {
    long L = (long)i * d.G + d.cid;
    if (d.sched == 0) {
        const int nwg = d.nM * d.nN;
        if (d.rev && nwg % d.G == 0) { const int rounds = nwg / d.G; if (i >= rounds) return false; L = (long)(rounds - 1 - i) * d.G + d.cid; }
        if (L >= nwg) return false;
        int wgid = (int)L; { const int q = nwg / NXCD, r = nwg % NXCD, xcd = wgid % NXCD, off = wgid / NXCD; wgid = (xcd < r ? xcd * (q + 1) : r * (q + 1) + (xcd - r) * q) + off; }
        const int nig = WGM * d.nN, gid = wgid / nig, fm = gid * WGM, gsz = (d.nM - fm) < WGM ? (d.nM - fm) : WGM;
        u.pm = fm + ((wgid % nig) % gsz); u.pn = (wgid % nig) / gsz; u.b = 0; u.h = 0; return true;
    } else {
        if (L >= 1024) return false;
        u.pm = (int)(L & 255); u.h = (int)(L >> 8); u.b = u.pm >> 5; u.pn = 0; return true;
    }
}
__device__ __forceinline__ const char* unit_a(const GemmDesc& d, const Unit& u) { return d.A + (size_t)u.pm * 256 * d.lda * 2 + (size_t)u.h * d.a_h; }
__device__ __forceinline__ const char* unit_b(const GemmDesc& d, const Unit& u) { return d.B + (size_t)u.pn * 256 * d.ldb * 2 + (size_t)u.b * d.b_b + (size_t)u.h * d.b_h; }

template <int EPI>
__device__ __forceinline__ void epilogue(const GemmDesc& d, f32x4 (&acc)[2][2][4][2], const Unit& u, int wr, int wc, int fr, int fq, LAS unsigned char* lds, int parity) {
    const int row0 = u.pm * BM + wr * 64 + fr;
    if constexpr (EPI == EPI_BF16) {
        bf16_t* O = (bf16_t*)d.O; const int ldc = d.ldc;
        const int ctile = u.pn * BM, col0 = d.col_off + u.h * d.col_h + ctile + wc * 32 + 8 * fq;
        const bool rope0 = (wc == 0) && (ctile < d.rope_limit), rope1 = (wc == 0) && (ctile + HALF < d.rope_limit);
        const float sgn = fq < 2 ? -1.f : 1.f;
        f32x4 cs[2][2];
#pragma unroll
        for (int bj = 0; bj < 2; ++bj)
#pragma unroll
            for (int n = 0; n < 2; ++n) cs[bj][n] = d.colscale ? *(const f32x4*)(d.colscale + col0 + bj * HALF + 4 * n) : (f32x4){1.f, 1.f, 1.f, 1.f};
#pragma unroll
        for (int ai = 0; ai < 2; ++ai)
#pragma unroll
            for (int m = 0; m < 4; ++m) {
                const int row = row0 + ai * HALF + m * 16; bf16_t* rowp = O + (size_t)row * ldc + col0;
                float rs = 1.f; if (d.ssq_in) { const f32x4 pr = *(const LAS f32x4*)(lds + LDS_STATS + parity * 4096 + (ai * HALF + wr * 64 + m * 16 + fr) * 16); rs = __builtin_amdgcn_rsqf(((pr[0] + pr[1]) + (pr[2] + pr[3])) * (1.f / DM) + 1e-6f); }
                f32x4 c0 = {1.f, 1.f, 1.f, 1.f}, c1 = c0, s0 = {0.f, 0.f, 0.f, 0.f}, s1 = s0;
                if (rope0 || rope1) { const int pos = row & (SEQ - 1); const float* cp = d.cosT + pos * 16 + 8 * (fq & 1); const float* sp = d.sinT + pos * 16 + 8 * (fq & 1);
                    c0 = *(const f32x4*)cp; c1 = *(const f32x4*)(cp + 4); s0 = *(const f32x4*)sp; s1 = *(const f32x4*)(sp + 4); }
#pragma unroll
                for (int bj = 0; bj < 2; ++bj) { f32x4 v0 = acc[ai][bj][m][0] * rs, v1 = acc[ai][bj][m][1] * rs;
                    if (bj == 0 ? rope0 : rope1) {
#pragma unroll
                        for (int e = 0; e < 4; ++e) { const float p0 = other32(v0[e], fq >= 2), p1 = other32(v1[e], fq >= 2);
                            v0[e] = v0[e] * c0[e] + sgn * p0 * s0[e]; v1[e] = v1[e] * c1[e] + sgn * p1 * s1[e]; } }
                    v0 = v0 * cs[bj][0]; v1 = v1 * cs[bj][1];
                    u32x4 w; w.x = cvt_pk_bf16(v0[0], v0[1]); w.y = cvt_pk_bf16(v0[2], v0[3]); w.z = cvt_pk_bf16(v1[0], v1[1]); w.w = cvt_pk_bf16(v1[2], v1[3]);
                    *(u32x4*)(rowp + bj * HALF) = w; } }
    } else if constexpr (EPI == EPI_RES) {
        bf16_t* HBp = d.hb; float* ssq = d.ssq_out; const int ldc = d.ldc;
        LAS float* stp = (LAS float*)(lds + LDS_STATS + parity * 8192);
        const int col0 = u.pn * BM + wc * 32 + 8 * fq;
#pragma unroll
        for (int ai = 0; ai < 2; ++ai)
#pragma unroll
            for (int m = 0; m < 4; ++m) { const int row = row0 + ai * HALF + m * 16; bf16_t* rowp = HBp + (size_t)row * ldc + col0; float ss = 0.f;
#pragma unroll
                for (int bj = 0; bj < 2; ++bj) { const u32x4 q = *(const u32x4*)(rowp + bj * HALF); const f32x4 a0 = acc[ai][bj][m][0], a1 = acc[ai][bj][m][1];
                    u32x4 w; w.x = cvt_pk_bf16(bf_lo(q.x) + a0[0], bf_hi(q.x) + a0[1]); w.y = cvt_pk_bf16(bf_lo(q.y) + a0[2], bf_hi(q.y) + a0[3]);
                    w.z = cvt_pk_bf16(bf_lo(q.z) + a1[0], bf_hi(q.z) + a1[1]); w.w = cvt_pk_bf16(bf_lo(q.w) + a1[2], bf_hi(q.w) + a1[3]);
                    *(u32x4*)(rowp + bj * HALF) = w;
                    const float h0 = bf_lo(w.x), h1 = bf_hi(w.x), h2 = bf_lo(w.y), h3 = bf_hi(w.y), h4 = bf_lo(w.z), h5 = bf_hi(w.z), h6 = bf_lo(w.w), h7 = bf_hi(w.w);
                    ss += ((h0 * h0 + h1 * h1) + (h2 * h2 + h3 * h3)) + ((h4 * h4 + h5 * h5) + (h6 * h6 + h7 * h7)); }
                ss += swz<16>(ss); ss = sum32(ss);
                if (fq == 0) stp[(ai * HALF + wr * 64 + m * 16 + fr) * 4 + wc] = ss;
                if (m & 1) asm volatile("" ::: "memory"); }
        asm volatile("s_waitcnt lgkmcnt(0)" ::: "memory"); __builtin_amdgcn_s_barrier(); asm volatile("" ::: "memory");
        if (wc == 0 && fq == 0) {
#pragma unroll
            for (int ai = 0; ai < 2; ++ai)
#pragma unroll
                for (int m = 0; m < 4; ++m) { const int rl = ai * HALF + wr * 64 + m * 16 + fr; const LAS float* q = stp + rl * 4;
                    ssq[(size_t)(u.pm * BM + rl) * 4 + u.pn] = (q[0] + q[1]) + (q[2] + q[3]); }
        }
    } else if constexpr (EPI == EPI_SWIGLU) {
        bf16_t* O = (bf16_t*)d.O; const int ldc = d.ldc;
        const int col0 = u.pn * HALF + wc * 32 + 8 * fq;
#pragma unroll
        for (int ai = 0; ai < 2; ++ai)
#pragma unroll
            for (int m = 0; m < 4; ++m) { const int row = row0 + ai * HALF + m * 16; bf16_t* rowp = O + (size_t)row * ldc + col0; float r[8];
                const f32x4 pr = *(const LAS f32x4*)(lds + LDS_STATS + parity * 4096 + (ai * HALF + wr * 64 + m * 16 + fr) * 16); const float rs = __builtin_amdgcn_rsqf(((pr[0] + pr[1]) + (pr[2] + pr[3])) * (1.f / DM) + 1e-6f);
#pragma unroll
                for (int n = 0; n < 2; ++n)
#pragma unroll
                    for (int e = 0; e < 4; ++e) { const float g = acc[ai][0][m][n][e] * rs, up = acc[ai][1][m][n][e] * rs;
                        r[n * 4 + e] = g * __builtin_amdgcn_rcpf(1.f + __builtin_amdgcn_exp2f(-1.4426950408889634f * g)) * up; }
                u32x4 w; w.x = cvt_pk_bf16(r[0], r[1]); w.y = cvt_pk_bf16(r[2], r[3]); w.z = cvt_pk_bf16(r[4], r[5]); w.w = cvt_pk_bf16(r[6], r[7]);
                *(u32x4*)rowp = w; }
    } else {
        bf16_t* O = (bf16_t*)d.O; const int ldc = d.ldc;
        const int col0 = d.col_off + u.h * d.col_h + wc * 32 + 8 * fq;
        constexpr float C = 1.4426950408889634f * 0.0625f;
        LAS f32x2* st = (LAS f32x2*)(lds + LDS_STATS + parity * 8192);
        float mw[2][4];
#pragma unroll
        for (int ai = 0; ai < 2; ++ai)
#pragma unroll
            for (int m = 0; m < 4; ++m) {
                float mx = -3.0e38f;
#pragma unroll
                for (int bj = 0; bj < 2; ++bj)
#pragma unroll
                    for (int n = 0; n < 2; ++n) { const f32x4 x = acc[ai][bj][m][n]; mx = fmaxf(mx, fmaxf(fmaxf(x[0], x[1]), fmaxf(x[2], x[3]))); }
                mx = fmaxf(mx, swz<16>(mx)); mx = max32(mx);
                float s = 0.f;
#pragma unroll
                for (int bj = 0; bj < 2; ++bj)
#pragma unroll
                    for (int n = 0; n < 2; ++n) { f32x4 x = acc[ai][bj][m][n];
#pragma unroll
                        for (int e = 0; e < 4; ++e) { x[e] = __builtin_amdgcn_exp2f((x[e] - mx) * C); s += x[e]; }
                        acc[ai][bj][m][n] = x; }
                s += swz<16>(s); s = sum32(s);
                mw[ai][m] = mx;
                if (fq == 0) st[(ai * HALF + wr * 64 + m * 16 + fr) * 4 + wc] = (f32x2){mx, s};
            }
        asm volatile("s_waitcnt lgkmcnt(0)" ::: "memory"); __builtin_amdgcn_s_barrier(); asm volatile("" ::: "memory");
#pragma unroll
        for (int ai = 0; ai < 2; ++ai)
#pragma unroll
            for (int m = 0; m < 4; ++m) {
                const int rl = ai * HALF + wr * 64 + m * 16 + fr;
                const f32x2 a = st[rl * 4 + 0], b = st[rl * 4 + 1], c = st[rl * 4 + 2], e4 = st[rl * 4 + 3];
                const float M = fmaxf(fmaxf(a.x, b.x), fmaxf(c.x, e4.x));
                const float S = a.y * __builtin_amdgcn_exp2f((a.x - M) * C) + b.y * __builtin_amdgcn_exp2f((b.x - M) * C) + c.y * __builtin_amdgcn_exp2f((c.x - M) * C) + e4.y * __builtin_amdgcn_exp2f((e4.x - M) * C);
                const float f = __builtin_amdgcn_exp2f((mw[ai][m] - M) * C) / S;
                bf16_t* rowp = O + (size_t)(u.pm * BM + rl) * ldc + col0;
#pragma unroll
                for (int bj = 0; bj < 2; ++bj) { const f32x4 v0 = acc[ai][bj][m][0] * f, v1 = acc[ai][bj][m][1] * f;
                    u32x4 w; w.x = cvt_pk_bf16(v0[0], v0[1]); w.y = cvt_pk_bf16(v0[2], v0[3]); w.z = cvt_pk_bf16(v1[0], v1[1]); w.w = cvt_pk_bf16(v1[2], v1[3]);
                    *(u32x4*)(rowp + bj * HALF) = w; } }
    }
}
#ifndef PG8_ALIGN_ALL
#define PG8_ALIGN_ALL true
#endif
template <int EPI>
__device__ __forceinline__ void gemm_phase(LAS unsigned char* lds, const GemmDesc& g) {
    int tid_ = threadIdx.x; asm volatile("" : "+v"(tid_));
    const int tid = tid_, wid = __builtin_amdgcn_readfirstlane(tid >> 6), lane = tid & 63, wr = wid >> 2, wc = wid & 3, fr = lane & 15, fq = lane >> 4;
    const int K = g.K, nt = K / BK;
    constexpr bool perm = true;
    unsigned voffA[2], voffB[2];
#pragma unroll
    for (int i = 0; i < 2; ++i) { int R, C; stage_rc(tid * 16 + i * 8192, R, C); const int Rb = perm ? ((R & ~31) + perm32(R & 31)) : R;
        voffA[i] = (unsigned)(R * g.lda + C) * 2u; voffB[i] = (unsigned)(Rb * g.ldb + C) * 2u; }
    const size_t kstep = (size_t)(BK * 2);
    const size_t hstepA = (size_t)HALF * g.lda * 2, hstepB = (size_t)HALF * g.ldb * 2;
    const unsigned ldsw = (unsigned)wid * 1024u;
    const int aoff = lds_byte(wr * 64 + fr, fq * 8), boff = lds_byte(wc * 32 + fr, fq * 8);
#define PG8_SA(b, h) (((b) * 2 + (h)) * HTB)
#define PG8_SB(b, h) ((4 + (b) * 2 + (h)) * HTB)
#define PG8_STAGE(bufoff, gbase, voff) do { _Pragma("unroll") for (int _i = 0; _i < 2; ++_i) \
        __builtin_amdgcn_global_load_lds((const unsigned*)((const char*)(gbase) + (voff)[_i]), (LAS unsigned*)(lds + (bufoff) + ldsw + _i * 8192), 16, 0, 0); } while (0)
#define PG8_LDA(dst, b, h) do { _Pragma("unroll") for (int m = 0; m < 4; ++m) _Pragma("unroll") for (int k = 0; k < 2; ++k) dst[m][k] = *(const LAS bf16x8*)(lds + PG8_SA(b, h) + aoff + m * 2048 + k * 1024); } while (0)
#define PG8_LDB(dst, b, h) do { _Pragma("unroll") for (int n = 0; n < 2; ++n) _Pragma("unroll") for (int k = 0; k < 2; ++k) dst[n][k] = *(const LAS bf16x8*)(lds + PG8_SB(b, h) + boff + n * 2048 + k * 1024); } while (0)
#define PG8_MMA(ai, bj, At, Bt) do { __builtin_amdgcn_s_setprio(1); _Pragma("unroll") for (int m = 0; m < 4; ++m) _Pragma("unroll") for (int n = 0; n < 2; ++n) _Pragma("unroll") for (int k = 0; k < 2; ++k) \
        acc[ai][bj][m][n] = __builtin_amdgcn_mfma_f32_16x16x32_bf16(Bt[n][k], At[m][k], acc[ai][bj][m][n], 0, 0, 0); __builtin_amdgcn_s_setprio(0); } while (0)
#define PG8_WAIT_V(n) asm volatile("s_waitcnt vmcnt(" #n ")" ::: "memory")
#define PG8_WAIT_L(n) asm volatile("s_waitcnt lgkmcnt(" #n ")" ::: "memory")
#define PG8_BAR __builtin_amdgcn_s_barrier()
#define PG8_SCHED __builtin_amdgcn_sched_barrier(0)
    const bool has_rs = (EPI == EPI_BF16 || EPI == EPI_SWIGLU) && g.ssq_in != nullptr;
#define PG8_ELOAD(un, par) do { if (has_rs && wid < 4) __builtin_amdgcn_global_load_lds((const unsigned*)(g.ssq_in + ((size_t)(un).pm * 256 + wid * 64 + lane) * 4), (LAS unsigned*)(lds + LDS_STATS + (par) * 4096 + wid * 1024), 16, 0, 0); } while (0)
    Unit cur, nxt; int ui = 0;
    if (!unit_next(g, 0, cur)) return;
    f32x4 acc[2][2][4][2];
    float z0; asm volatile("v_mov_b32 %0, 0" : "=v"(z0));
#pragma unroll
    for (int a = 0; a < 2; ++a)
#pragma unroll
        for (int b = 0; b < 2; ++b)
#pragma unroll
            for (int m = 0; m < 4; ++m)
#pragma unroll
                for (int n = 0; n < 2; ++n) acc[a][b][m][n] = (f32x4){z0, z0, z0, z0};
    bf16x8 At[4][2], B0[2][2], B1[2][2];
    const char* cA = unit_a(g, cur); const char* cB = unit_b(g, cur);
    PG8_ELOAD(cur, 0);
    PG8_STAGE(PG8_SB(0, 0), cB, voffB); PG8_STAGE(PG8_SB(0, 1), cB + hstepB, voffB); PG8_STAGE(PG8_SA(0, 0), cA, voffA); PG8_STAGE(PG8_SA(0, 1), cA + hstepA, voffA);
    if (wr == 1) PG8_BAR;
    PG8_WAIT_V(2); PG8_BAR;
    PG8_STAGE(PG8_SB(1, 0), cB + kstep, voffB); PG8_STAGE(PG8_SA(1, 0), cA + kstep, voffA); PG8_STAGE(PG8_SB(1, 1), cB + hstepB + kstep, voffB);
    PG8_WAIT_V(6); PG8_BAR;
    for (;;) {
        const bool has_next = unit_next(g, ui + 1, nxt);
        const char* nA = has_next ? unit_a(g, nxt) : cA; const char* nB = has_next ? unit_b(g, nxt) : cB;
        for (int t = 0; t < nt; t += 2) {
            const bool last = (t == nt - 2);
            const char* a1 = cA + (size_t)(t + 1) * kstep;
            const char* a2 = last ? nA : cA + (size_t)(t + 2) * kstep; const char* b2 = last ? nB : cB + (size_t)(t + 2) * kstep;
            const char* a3 = a2 + kstep; const char* b3 = b2 + kstep;
            if (last && has_next) PG8_ELOAD(nxt, (ui + 1) & 1);
            PG8_LDB(B0, 0, 0); PG8_LDB(B1, 0, 1); PG8_SCHED; PG8_LDA(At, 0, 0); PG8_STAGE(PG8_SA(1, 1), a1 + hstepA, voffA);
            PG8_WAIT_V(8); PG8_WAIT_L(0); PG8_BAR; PG8_MMA(0, 0, At, B0); PG8_MMA(0, 1, At, B1); PG8_BAR; PG8_SCHED;
            PG8_LDA(At, 0, 1); PG8_STAGE(PG8_SB(0, 0), b2, voffB); PG8_STAGE(PG8_SB(0, 1), b2 + hstepB, voffB); PG8_STAGE(PG8_SA(0, 0), a2, voffA);
            PG8_WAIT_V(8); PG8_WAIT_L(0); PG8_BAR; PG8_MMA(1, 0, At, B0); PG8_MMA(1, 1, At, B1); PG8_BAR; PG8_SCHED;
            PG8_LDB(B0, 1, 0); PG8_LDB(B1, 1, 1); PG8_SCHED; PG8_LDA(At, 1, 0); PG8_STAGE(PG8_SA(0, 1), a2 + hstepA, voffA);
            PG8_WAIT_V(8); PG8_WAIT_L(0); PG8_BAR; PG8_MMA(0, 0, At, B0); PG8_MMA(0, 1, At, B1); PG8_BAR; PG8_SCHED;
            PG8_LDA(At, 1, 1); PG8_STAGE(PG8_SB(1, 0), b3, voffB); PG8_STAGE(PG8_SB(1, 1), b3 + hstepB, voffB); PG8_STAGE(PG8_SA(1, 0), a3, voffA);
            PG8_WAIT_V(8); PG8_WAIT_L(0); PG8_BAR; PG8_MMA(1, 0, At, B0); PG8_MMA(1, 1, At, B1); PG8_BAR; PG8_SCHED;
        }
        constexpr bool ALIGN = (EPI == EPI_RES || EPI == EPI_SOFTMAX) || PG8_ALIGN_ALL;
        if (ALIGN) { if (wr == 0) PG8_BAR; }
        epilogue<EPI>(g, acc, cur, wr, wc, fr, fq, lds, ui & 1);
        if (!has_next) break;
        float z1; asm volatile("v_mov_b32 %0, 0" : "=v"(z1));
#pragma unroll
        for (int a = 0; a < 2; ++a)
#pragma unroll
            for (int b = 0; b < 2; ++b)
#pragma unroll
                for (int m = 0; m < 4; ++m)
#pragma unroll
                    for (int n = 0; n < 2; ++n) acc[a][b][m][n] = (f32x4){z1, z1, z1, z1};
        cur = nxt; cA = nA; cB = nB; ++ui;
        if (ALIGN) { if (wr == 1) PG8_BAR; }
    }
    PG8_WAIT_V(0);
    if (!((EPI == EPI_RES || EPI == EPI_SOFTMAX) || PG8_ALIGN_ALL)) { if (wr == 0) PG8_BAR; }
    PG8_BAR;
#undef PG8_SA
#undef PG8_SB
#undef PG8_STAGE
#undef PG8_LDA
#undef PG8_LDB
#undef PG8_MMA
#undef PG8_WAIT_V
#undef PG8_WAIT_L
#undef PG8_BAR
#undef PG8_SCHED
#undef PG8_ELOAD
}
}
namespace att {
constexpr int D = 128, LDQ = 2048, LDKV = 2048, LDO = LDCAT;
constexpr float SCALE = 0.08838834764831845f;
constexpr float THR = 8.f;
constexpr bool WSKIP = false;
constexpr int NW = 8, QBLK = 32, KVBLK = 64, QB = NW * QBLK;
constexpr int SHM_V = KVBLK * D * 2, SHM_K = KVBLK * D * 2;
constexpr int ATT_LDS_BYTES = 2 * SHM_V + 2 * SHM_K + NW * 64 * 4;
#define KSWZ(row, colB) ((row) * 256 + ((colB) ^ (((row) & 7) << 4)))
#define SBAR() __builtin_amdgcn_sched_barrier(0)
__device__ __forceinline__ int v_st(int k, int c) { const int kk = (k & ~0xC) | ((k & 4) << 1) | ((k & 8) >> 1); return ((kk >> 3) * 4 + (c >> 5)) * 512 + ((kk & 7) * 32 + (c & 31)) * 2; }
__device__ __forceinline__ int v_rd_base(int lane) { return ((lane & 3) << 3) | (((lane >> 2) & 3) << 6) | (((lane >> 4) & 1) << 5) | (((lane >> 5) & 1) << 8); }
constexpr int v_rd_off(int d0, int ks, int half) { return d0 * 512 + ks * 4096 + half * 2048; }
__device__ __forceinline__ int crow(int r, int hi) { return (r & 3) + 8 * (r >> 2) + 4 * hi; }
__device__ __forceinline__ unsigned cvtpk(float lo, float hi) {
    unsigned r; asm volatile("v_cvt_pk_bf16_f32 %0, %1, %2" : "=v"(r) : "v"(lo), "v"(hi)); return r;
}
__device__ __forceinline__ bf16x8 pack8(f32x4 a, f32x4 b) {
    u32x4 w = {cvtpk(a[0], a[1]), cvtpk(a[2], a[3]), cvtpk(b[0], b[1]), cvtpk(b[2], b[3])};
    return *reinterpret_cast<bf16x8*>(&w);
}
template <class T> __device__ __forceinline__ bf16x8 load8(const T* p) {
    if constexpr (same_t<T, float>::v) { return pack8(*(const f32x4*)p, *(const f32x4*)(p + 4)); }
    else { return *reinterpret_cast<const bf16x8*>(p); }
}
__device__ __forceinline__ void mask_tile(f32x16& p0, f32x16& p1, int dq, unsigned W) {
    const float NEG = -__builtin_inff();
#pragma unroll
    for (int r = 0; r < 16; ++r) {
        const int c = (r & 3) + 8 * (r >> 2);
        if ((unsigned)(dq - c) >= W) p0[r] = NEG;
        if ((unsigned)(dq - c - 32) >= W) p1[r] = NEG;
    }
}
__device__ __forceinline__ void partialSM(f32x16& p0, f32x16& p1, float& m_reg, float& mn, float& alpha) {
    float pmax = p0[0]; for (int r = 1; r < 16; ++r) pmax = fmaxf(pmax, p0[r]); for (int r = 0; r < 16; ++r) pmax = fmaxf(pmax, p1[r]);
    { auto rr = __builtin_amdgcn_permlane32_swap(__float_as_uint(pmax), __float_as_uint(pmax), false, false);
      pmax = fmaxf(__uint_as_float(rr[0]), __uint_as_float(rr[1])); }
    constexpr float C2 = 1.4426950408889634f * SCALE;
    if (__builtin_expect(__all((pmax - m_reg) * SCALE <= THR), 1)) { mn = m_reg; alpha = 1.f; }
    else { mn = fmaxf(m_reg, pmax); alpha = __builtin_amdgcn_exp2f((m_reg - mn) * C2); m_reg = mn; }
    const float mnL = -mn * C2;
    for (int r = 0; r < 16; ++r) p0[r] = fmaf(p0[r], C2, mnL); for (int r = 0; r < 16; ++r) p1[r] = fmaf(p1[r], C2, mnL);
    for (int r = 0; r < 16; ++r) p0[r] = __builtin_amdgcn_exp2f(p0[r]);
}
__device__ __forceinline__ void finishSM(f32x16& p0, f32x16& p1, float alpha, float& l_reg, bf16x8& pa0, bf16x8& pa1, bf16x8& pa2, bf16x8& pa3) {
    for (int r = 0; r < 16; ++r) p1[r] = __builtin_amdgcn_exp2f(p1[r]);
    float ps = 0; for (int r = 0; r < 16; ++r) ps += p0[r]; for (int r = 0; r < 16; ++r) ps += p1[r];
    { auto rr = __builtin_amdgcn_permlane32_swap(__float_as_uint(ps), __float_as_uint(ps), false, false);
      ps = __uint_as_float(rr[0]) + __uint_as_float(rr[1]); }
    l_reg = l_reg * alpha + ps;
#define PK4(P, B_, OUT) do { unsigned a0 = cvtpk(P[B_+0], P[B_+1]), a1 = cvtpk(P[B_+2], P[B_+3]);                          \
        unsigned b0 = cvtpk(P[B_+4], P[B_+5]), b1 = cvtpk(P[B_+6], P[B_+7]);                                             \
        auto r0 = __builtin_amdgcn_permlane32_swap(a0, b0, false, false); auto r1 = __builtin_amdgcn_permlane32_swap(a1, b1, false, false); \
        u32x4 w = {r0[0], r1[0], r0[1], r1[1]}; OUT = *reinterpret_cast<bf16x8*>(&w); } while (0)
    PK4(p0, 0, pa0); PK4(p0, 8, pa1); PK4(p1, 0, pa2); PK4(p1, 8, pa3);
#undef PK4
}
template <int KB, bool SK>
__device__ __forceinline__ void qkt(f32x16& p0, f32x16& p1, const char* K_lds, int r32, int hi, const bf16x8* qr, bool act) {
    if (SK && !act) { const float NEG = -__builtin_inff();
#pragma unroll
        for (int r = 0; r < 16; ++r) { p0[r] = NEG; p1[r] = NEG; } return; }
    p0 = f32x16{}; p1 = f32x16{};
    const char* kb[4];
#pragma unroll
    for (int dd = 0; dd < 4; ++dd) kb[dd] = K_lds + KB * SHM_K + KSWZ(r32, (dd * 16 + hi * 8) * 2);
#pragma unroll
    for (int d0 = 0; d0 < 8; ++d0) { const char* a = kb[d0 & 3] + (d0 >> 2) * 128;
        bf16x8 b0 = *reinterpret_cast<const bf16x8*>(a);
        bf16x8 b1 = *reinterpret_cast<const bf16x8*>(a + 32 * 256);
        p0 = __builtin_amdgcn_mfma_f32_32x32x16_bf16(b0, qr[d0], p0, 0, 0, 0);
        p1 = __builtin_amdgcn_mfma_f32_32x32x16_bf16(b1, qr[d0], p1, 0, 0, 0); }
}
template <int VB, bool SK>
__device__ __forceinline__ void pv_tile(f32x16* o, int vb0, bf16x8 pa0, bf16x8 pa1, bf16x8 pa2, bf16x8 pa3, bool act) {
    if (SK && !act) return;
#define TRRD(dst, off) asm volatile("ds_read_b64_tr_b16 %0, %1 offset:%2" : "=&v"(dst) : "v"(vb0), "i"(off) : "memory")
#define PV_D0(d0) do { s16x4 l0, l1, l2, l3, h0, h1, h2, h3; constexpr int b_ = VB * SHM_V + v_rd_off(d0, 0, 0);     \
        TRRD(l0, b_); TRRD(h0, b_ + 2048); TRRD(l1, b_ + 4096); TRRD(h1, b_ + 6144); TRRD(l2, b_ + 8192); TRRD(h2, b_ + 10240); TRRD(l3, b_ + 12288); TRRD(h3, b_ + 14336); \
        asm volatile("s_waitcnt lgkmcnt(0)" ::: "memory"); SBAR();                 \
        o[d0] = __builtin_amdgcn_mfma_f32_32x32x16_bf16(pa0, (bf16x8){l0[0], l0[1], l0[2], l0[3], h0[0], h0[1], h0[2], h0[3]}, o[d0], 0, 0, 0);   \
        o[d0] = __builtin_amdgcn_mfma_f32_32x32x16_bf16(pa1, (bf16x8){l1[0], l1[1], l1[2], l1[3], h1[0], h1[1], h1[2], h1[3]}, o[d0], 0, 0, 0);   \
        o[d0] = __builtin_amdgcn_mfma_f32_32x32x16_bf16(pa2, (bf16x8){l2[0], l2[1], l2[2], l2[3], h2[0], h2[1], h2[2], h2[3]}, o[d0], 0, 0, 0);   \
        o[d0] = __builtin_amdgcn_mfma_f32_32x32x16_bf16(pa3, (bf16x8){l3[0], l3[1], l3[2], l3[3], h3[0], h3[1], h3[2], h3[3]}, o[d0], 0, 0, 0); } while (0)
    PV_D0(0); PV_D0(1); PV_D0(2); PV_D0(3);
#undef PV_D0
#undef TRRD
}

template <class TIn, class TOut> struct BlockRef { const TIn* Q; const TIn* K; const TIn* V; TOut* O; int P0; int mode; };
template <class TIn> struct Seam {
    bf16x8 qr[8];
    bf16x8 st_v0, st_v1, st_k0, st_k1; f32x4 sf0, sf1, sf2, sf3;
    f32x4 tq[16];
};
__device__ __forceinline__ int swa_jlo(int P0, int W) { const int lowk = P0 - W + 1; return lowk > 0 ? lowk / KVBLK : 0; }
#define ROW(p, k0, rr) ((p) + (size_t)((k0) + (rr)) * LDKV + sc)
#define VMW() asm volatile("s_waitcnt vmcnt(0)" ::: "memory")
#define VMWN(n) asm volatile("s_waitcnt vmcnt(%0)" :: "i"(n) : "memory")
#define SLOAD_H(Kp, Vp, k0) do { S.st_v0 = load8<TIn>(ROW(Vp, k0, sr)); S.st_v1 = load8<TIn>(ROW(Vp, k0, 32 + sr));              \
                         S.st_k0 = load8<TIn>(ROW(Kp, k0, sr)); S.st_k1 = load8<TIn>(ROW(Kp, k0, 32 + sr)); } while (0)
#define SWRITE_HK(bf) do { *(bf16x8*)(K_lds + (bf) * SHM_K + kws) = S.st_k0; *(bf16x8*)(K_lds + (bf) * SHM_K + kws + 32 * 256) = S.st_k1; } while (0)
#define SWRITE_HV(bf) do { *(bf16x8*)(V_lds + (bf) * SHM_V + vst0) = S.st_v0; *(bf16x8*)(V_lds + (bf) * SHM_V + vst1) = S.st_v1; } while (0)
#define SWRITE_H(bf) do { SWRITE_HV(bf); SWRITE_HK(bf); } while (0)
#define SLOAD_F(p, k0) do { S.sf0 = *(const f32x4*)ROW(p, k0, sr); S.sf1 = *(const f32x4*)(ROW(p, k0, sr) + 4);                \
                            S.sf2 = *(const f32x4*)ROW(p, k0, 32 + sr); S.sf3 = *(const f32x4*)(ROW(p, k0, 32 + sr) + 4); } while (0)
#define SWRITE_KF(bf) do { *(bf16x8*)(K_lds + (bf) * SHM_K + kws) = pack8(S.sf0, S.sf1); *(bf16x8*)(K_lds + (bf) * SHM_K + kws + 32 * 256) = pack8(S.sf2, S.sf3); } while (0)
#define SWRITE_VF(bf) do { *(bf16x8*)(V_lds + (bf) * SHM_V + vst0) = pack8(S.sf0, S.sf1); *(bf16x8*)(V_lds + (bf) * SHM_V + vst1) = pack8(S.sf2, S.sf3); } while (0)
template <class TIn, class TOut>
__device__ __forceinline__ void causal_swa_prime(const BlockRef<TIn, TOut>& cur, int W, char* lds, Seam<TIn>& S) {
    constexpr bool F32 = same_t<TIn, float>::v;
    int tid_ = threadIdx.x; asm volatile("" : "+v"(tid_));
    const int tid = tid_, wid = __builtin_amdgcn_readfirstlane(tid >> 6), lane = tid & 63, r32 = lane & 31, hi = lane >> 5;
    const int sr = tid >> 4, sc = (tid & 15) * 8, kws = KSWZ(sr, sc * 2); char* K_lds = lds + 2 * SHM_V;
    const int kb0 = swa_jlo(cur.P0, W) * KVBLK;
    for (int d0 = 0; d0 < 8; ++d0) S.qr[d0] = load8<TIn>(cur.Q + (size_t)(wid * QBLK + r32) * LDQ + d0 * 16 + hi * 8);
    if constexpr (F32) { SLOAD_F((const float*)cur.K, kb0); VMW(); SWRITE_KF(0); SBAR(); SLOAD_F((const float*)cur.V, kb0); }
    else { SLOAD_H(cur.K, cur.V, kb0); VMW(); SWRITE_HK(0); }
    __syncthreads();
}
template <class TIn, class TOut>
__device__ __forceinline__ void causal_swa_block(const BlockRef<TIn, TOut>& cur, const BlockRef<TIn, TOut>& nxt, int skv, int W, char* lds, Seam<TIn>& S, float lam) {
    constexpr bool F32 = same_t<TIn, float>::v;
    int tid_ = threadIdx.x; asm volatile("" : "+v"(tid_));
    const int tid = tid_, wid = __builtin_amdgcn_readfirstlane(tid >> 6), lane = tid & 63, r32 = lane & 31, hi = lane >> 5;
    const int j_lo = swa_jlo(cur.P0, W);
    int j_hi = (cur.P0 + QB - 1) / KVBLK + 1; if (j_hi > skv / KVBLK) j_hi = skv / KVBLK;
    const int NT = j_hi - j_lo;
    const int kbn = swa_jlo(nxt.P0, W) * KVBLK;
    const int qlo = cur.P0 + wid * QBLK, qm = qlo + r32 - 4 * hi;
    char* V_lds = lds; char* K_lds = lds + 2 * SHM_V;
    float* ws = (float*)(lds + 2 * SHM_V + 2 * SHM_K) + wid * 64; float* li_l = ws, * al_l = ws + 32;
    float m_reg = -1e30f, l_reg = 0; f32x16 o[4] = {};
    const int sr = tid >> 4, sc = (tid & 15) * 8, vst0 = v_st(sr, sc), vst1 = v_st(32 + sr, sc), kws = KSWZ(sr, sc * 2);
    const int vb0 = (int)(uintptr_t)V_lds + v_rd_base(lane);
    const TIn* Kh = cur.K; const TIn* Vh = cur.V;
#define RESC(a) do { if (__any((a) < 1.f)) { if (hi == 0) al_l[r32] = (a); asm volatile("s_waitcnt lgkmcnt(0)" ::: "memory");              \
                     for (int d_ = 0; d_ < 4; ++d_) for (int r = 0; r < 16; ++r) o[d_][r] *= al_l[crow(r, hi)]; } } while (0)
#define KBASE(t) ((j_lo + (t)) * KVBLK)
#define ACT(t) (KBASE(t) <= qlo + QBLK - 1 && KBASE(t) + KVBLK - 1 >= qlo - W + 1)
#define MASKT(P0_, P1_, t) do { const int kb_ = KBASE(t); if ((!SK || ACT(t)) && (kb_ + KVBLK - 1 > qlo || kb_ <= qlo + QBLK - 1 - W)) mask_tile(P0_, P1_, qm - kb_, (unsigned)W); } while (0)
    constexpr int NQL = F32 ? 16 : 8;
    constexpr bool SK = WSKIP && !F32;
#define SEAM_K0() do { VMWN(NQL); if constexpr (F32) { SWRITE_KF(0); SBAR(); SLOAD_F((const float*)nxt.V, kbn); } else { SWRITE_HK(0); } SBAR(); } while (0)
    f32x16 pA0, pA1, pB0, pB1; float mnA, mnB, alA, alB; bf16x8 pa0, pa1, pa2, pa3;
    if constexpr (F32) { VMW(); SWRITE_VF(0); SBAR(); } else { SWRITE_HV(0); SBAR(); }
    if (NT > 1) { if constexpr (F32) SLOAD_F((const float*)Kh, KBASE(1)); else SLOAD_H(Kh, Vh, KBASE(1)); }
    SBAR(); qkt<0, SK>(pA0, pA1, K_lds, r32, hi, S.qr, ACT(0));
    if constexpr (F32) { if (NT > 1) { VMW(); SWRITE_KF(1); SBAR(); SLOAD_F((const float*)Vh, KBASE(1)); } }
    MASKT(pA0, pA1, 0); partialSM(pA0, pA1, m_reg, mnA, alA);
    if (NT > 1) { VMW(); if constexpr (F32) { SWRITE_VF(1); SBAR(); if (NT > 2) SLOAD_F((const float*)Kh, KBASE(2)); } else SWRITE_H(1); }
    __syncthreads();
#define HALF_STEP(PX0, PX1, mnX, alX, PY0, PY1, alY, t, KB, VB, SB) do {                                                      \
        SBAR(); qkt<KB, SK>(PX0, PX1, K_lds, r32, hi, S.qr, ACT(t));                                             \
        finishSM(PY0, PY1, alY, l_reg, pa0, pa1, pa2, pa3); SBAR();                                                           \
        if ((t) + 1 < NT) { if constexpr (F32) { VMW(); SWRITE_KF(SB); SBAR(); SLOAD_F((const float*)Vh, KBASE((t) + 1)); }  \
                            else { SLOAD_H(Kh, Vh, KBASE((t) + 1)); } SBAR(); }                                               \
        pv_tile<VB, SK>(o, vb0, pa0, pa1, pa2, pa3, ACT((t) - 1)); MASKT(PX0, PX1, (t)); partialSM(PX0, PX1, m_reg, mnX, alX);                                        \
        __syncthreads();                                                                                                      \
        if ((t) + 1 < NT) { VMW(); if constexpr (F32) { SWRITE_VF(SB); SBAR(); if ((t) + 2 < NT) SLOAD_F((const float*)Kh, KBASE((t) + 2)); } \
                            else { SWRITE_H(SB); } }                                                                          \
        RESC(alX); __syncthreads(); } while (0)
    for (int t = 1; t + 1 < NT; t += 2) {
        HALF_STEP(pB0, pB1, mnB, alB, pA0, pA1, alA, t, 1, 0, 0);
        HALF_STEP(pA0, pA1, mnA, alA, pB0, pB1, alB, t + 1, 0, 1, 1);
    }
    const bool even = (NT & 1) == 0;
    if (even) { SBAR(); qkt<1, SK>(pB0, pB1, K_lds, r32, hi, S.qr, ACT(NT - 1)); SBAR(); }
#define QROW(e) (nxt.Q + (size_t)(wid * QBLK + r32) * D + ((e) >> 1) * 16 + hi * 8 + ((e) & 1) * 4)
    if constexpr (F32) { SLOAD_F((const float*)nxt.K, kbn); SBAR();
#pragma unroll
        for (int e = 0; e < 8; ++e) S.tq[e] = *(const f32x4*)QROW(e); }
    else { SLOAD_H(nxt.K, nxt.V, kbn); SBAR();
#pragma unroll
        for (int d0 = 0; d0 < 8; ++d0) S.qr[d0] = load8<TIn>(nxt.Q + (size_t)(wid * QBLK + r32) * LDQ + d0 * 16 + hi * 8); }
    SBAR();
    finishSM(pA0, pA1, alA, l_reg, pa0, pa1, pa2, pa3); SBAR();
    if constexpr (F32) {
#pragma unroll
        for (int e = 8; e < 16; ++e) S.tq[e] = *(const f32x4*)QROW(e); SBAR(); }
#undef QROW
    pv_tile<0, SK>(o, vb0, pa0, pa1, pa2, pa3, ACT(even ? NT - 2 : NT - 1));
    if (even) { MASKT(pB0, pB1, NT - 1); partialSM(pB0, pB1, m_reg, mnB, alB); __syncthreads(); RESC(alB);
        finishSM(pB0, pB1, alB, l_reg, pa0, pa1, pa2, pa3); SBAR(); pv_tile<1, SK>(o, vb0, pa0, pa1, pa2, pa3, ACT(NT - 1)); }
    SBAR(); SEAM_K0();
    if (hi == 0) li_l[r32] = l_reg; asm volatile("s_waitcnt lgkmcnt(0)" ::: "memory");
    float rli[16];
#pragma unroll
    for (int r = 0; r < 16; ++r) rli[r] = __builtin_amdgcn_rcpf(li_l[crow(r, hi)]);
    {
        unsigned* park = (unsigned*)(lds + ATT_LDS_BYTES) + (tid >> 1);
        TOut* op = cur.O + (size_t)(wid * QBLK + 4 * hi) * LDO + r32;
        const int md = cur.mode; const bool ev = (r32 & 1) == 0;
#pragma unroll
        for (int r = 0; r < 16; ++r) {
#pragma unroll
            for (int d0 = 0; d0 < 4; ++d0) { const float v = o[d0][r] * rli[r]; const float vn = swz<1>(v);
                if (md == 0) { if (ev) park[(r * 4 + d0) * 256] = cvtpk(v, vn); }
                else if (ev) { const unsigned w = park[(r * 4 + d0) * 256];
                    *(unsigned*)(op + d0 * 32) = cvtpk(__uint_as_float(w << 16) - lam * v, __uint_as_float(w & 0xffff0000u) - lam * vn); } }
            op += ((r & 3) == 3 ? 5 : 1) * LDO; asm volatile("" : "+v"(op));
        }
    }
    if constexpr (F32) {
#pragma unroll
        for (int d0 = 0; d0 < 8; ++d0) S.qr[d0] = pack8(S.tq[2 * d0], S.tq[2 * d0 + 1]); }
    __syncthreads();
#undef RESC
#undef KBASE
#undef ACT
#undef MASKT
#undef SEAM_K0
#undef HALF_STEP
}
#undef ROW
#undef VMW
#undef VMWN
#undef SLOAD_H
#undef SWRITE_HK
#undef SWRITE_HV
#undef SWRITE_H
#undef SLOAD_F
#undef SWRITE_KF
#undef SWRITE_VF
typedef BlockRef<bf16_t, bf16_t> BR;
__device__ __forceinline__ BR make_blk(int idx, int w, int G, const bf16_t* z, const bf16_t* kv, bf16_t* cat) {
    const int L = w + G * (idx >> 2);
    int b, h, e, y;
    if (G == 256) { const int xcd = w & 7, jx = w >> 3, bh = (idx >> 2) * 8 + xcd; b = bh >> 2; h = bh & 3; e = jx >> 4; y = jx & 15; }
    else { const int combo = L >> 4; y = L & 15; b = combo >> 3; h = (combo >> 1) & 3; e = combo & 1; }
    const int sub = idx & 3, qb = (sub >> 1) ? y : 31 - y, c = sub & 1;
    BR r;
    r.Q = z + (size_t)(b * SEQ + qb * QB) * LDQ + h * 256 + c * 128;
    r.K = kv + (size_t)(b * SEQ) * LDKV + h * 256 + c * 128;
    r.V = kv + (size_t)(b * SEQ) * LDKV + 1024 + h * 256 + e * 128;
    r.O = cat + (size_t)(b * SEQ + qb * QB) * LDO + h * 256 + e * 128;
    r.P0 = qb * QB; r.mode = c;
    return r;
}
__device__ __forceinline__ void attn_phase(char* lds, const bf16_t* z, const bf16_t* kv, bf16_t* cat, float lam, int w, int G) {
    int nitems = 0; for (int L = w; L < 1024; L += G) ++nitems;
    const int nblk = nitems * 4; if (nblk == 0) return;
    BR cur = make_blk(0, w, G, z, kv, cat);
    Seam<bf16_t> S;
    causal_swa_prime<bf16_t, bf16_t>(cur, SEQ, lds, S);
    for (int idx = 0; idx < nblk; ++idx) {
        const BR nxt = (idx + 1 < nblk) ? make_blk(idx + 1, w, G, z, kv, cat) : cur;
        causal_swa_block<bf16_t, bf16_t>(cur, nxt, SEQ, SEQ, lds, S, lam);
        cur = nxt;
    }
}
}

__device__ __forceinline__ void norm_rows(const float* src, const float* g, bf16_t* dst, int nrows, int gw, int NGW, int lane) {
    f32x4 gv[4];
#pragma unroll
    for (int j = 0; j < 4; ++j) gv[j] = ((const f32x4*)g)[lane + 64 * j];
    for (int m = gw; m < nrows; m += NGW) {
        const f32x4* xr = (const f32x4*)(src + (size_t)m * DM) + lane;
        f32x4 v[4]; float s = 0.f;
#pragma unroll
        for (int j = 0; j < 4; ++j) { v[j] = xr[64 * j]; s += (v[j].x * v[j].x + v[j].y * v[j].y) + (v[j].z * v[j].z + v[j].w * v[j].w); }
        const float rstd = __builtin_amdgcn_rsqf(wave_sum(s) * (1.f / DM) + 1e-6f);
        u32x2* o8 = (u32x2*)(dst + (size_t)m * DM) + lane;
#pragma unroll
        for (int j = 0; j < 4; ++j) { const f32x4 y = v[j] * rstd * gv[j]; u32x2 w; w.x = cvt_pk_bf16(y.x, y.y); w.y = cvt_pk_bf16(y.z, y.w); o8[64 * j] = w; }
    }
}
__device__ __forceinline__ void hb_rows(const float* src, bf16_t* dst, float* ssq, int nrows, int gw, int NGW, int lane) {
    for (int m = gw; m < nrows; m += NGW) {
        const f32x4* xr = (const f32x4*)(src + (size_t)m * DM) + lane;
        f32x4 v[4]; float s = 0.f;
#pragma unroll
        for (int j = 0; j < 4; ++j) { v[j] = xr[64 * j]; s += (v[j].x * v[j].x + v[j].y * v[j].y) + (v[j].z * v[j].z + v[j].w * v[j].w); }
        s = wave_sum(s);
        u32x2* o8 = (u32x2*)(dst + (size_t)m * DM) + lane;
#pragma unroll
        for (int j = 0; j < 4; ++j) { u32x2 w; w.x = cvt_pk_bf16(v[j].x, v[j].y); w.y = cvt_pk_bf16(v[j].z, v[j].w); o8[64 * j] = w; }
        if (lane == 0) *(f32x4*)(ssq + (size_t)m * 4) = (f32x4){s, 0.f, 0.f, 0.f};
    }
}
__device__ __forceinline__ void final_rows(const bf16_t* h, float* out, const float* g, int gw, int NGW, int lane) {
    f32x4 gv[4];
#pragma unroll
    for (int j = 0; j < 4; ++j) gv[j] = ((const f32x4*)g)[lane + 64 * j];
    for (int m = gw; m < MTOK; m += NGW) {
        const u32x2* xr = (const u32x2*)(h + (size_t)m * DM) + lane;
        f32x4 v[4]; float s = 0.f;
#pragma unroll
        for (int j = 0; j < 4; ++j) { const u32x2 q = xr[64 * j]; v[j] = (f32x4){bf_lo(q.x), bf_hi(q.x), bf_lo(q.y), bf_hi(q.y)}; s += (v[j].x * v[j].x + v[j].y * v[j].y) + (v[j].z * v[j].z + v[j].w * v[j].w); }
        const float rstd = __builtin_amdgcn_rsqf(wave_sum(s) * (1.f / DM) + 1e-6f);
        f32x4* orow = (f32x4*)(out + (size_t)m * DM) + lane;
#pragma unroll
        for (int j = 0; j < 4; ++j) orow[64 * j] = v[j] * rstd * gv[j];
    }
}
__device__ __forceinline__ void transpose_item(const float* W, int K, int N, bf16_t* WT, int ldw, int kb, int n0, int drow0, const float* gk, LAS float* scr, int lane) {
    const int k0 = 64 * kb;
    f32x4 v[8];
#pragma unroll
    for (int i = 0; i < 8; ++i) v[i] = *(const f32x4*)(W + (size_t)(k0 + 8 * i + (lane >> 3)) * N + n0 + (lane & 7) * 4);
#pragma unroll
    for (int i = 0; i < 8; ++i) { LAS float* q = scr + (8 * i + (lane >> 3)) * 33 + (lane & 7) * 4; q[0] = v[i][0]; q[1] = v[i][1]; q[2] = v[i][2]; q[3] = v[i][3]; }
    asm volatile("s_waitcnt lgkmcnt(0)" ::: "memory");
    const int c = lane & 7;
    f32x4 g0 = {1.f, 1.f, 1.f, 1.f}, g1 = g0;
    if (gk) { g0 = *(const f32x4*)(gk + k0 + 8 * c); g1 = *(const f32x4*)(gk + k0 + 8 * c + 4); }
#pragma unroll
    for (int j = 0; j < 4; ++j) { const int n = (lane >> 3) + 8 * j; const LAS float* s = scr + (8 * c) * 33 + n;
        u32x4 o; o.x = cvt_pk_bf16(s[0 * 33] * g0[0], s[1 * 33] * g0[1]); o.y = cvt_pk_bf16(s[2 * 33] * g0[2], s[3 * 33] * g0[3]); o.z = cvt_pk_bf16(s[4 * 33] * g1[0], s[5 * 33] * g1[1]); o.w = cvt_pk_bf16(s[6 * 33] * g1[2], s[7 * 33] * g1[3]);
        *(u32x4*)(WT + (size_t)(drow0 + n) * ldw + k0 + 8 * c) = o; }
    asm volatile("s_waitcnt lgkmcnt(0)" ::: "memory");
}
__device__ __forceinline__ void conv_matrix(const float* W, int K, int N, bf16_t* WT, int ldw, int mode  , const float* gk, LAS float* scr, int gw, int NGW, int lane) {
    const int nblk = N / 32, nitems = (K / 64) * nblk;
    for (int it = gw; it < nitems; it += NGW) {
        const int kb = it / nblk, n0 = (it % nblk) * 32;
        const int drow0 = mode == 0 ? n0 : 256 * (n0 >> 7) + (n0 & 127) + (mode == 2 ? 128 : 0);
        transpose_item(W, K, N, WT, ldw, kb, n0, drow0, gk, scr, lane);
    }
}
__device__ __forceinline__ void pool_phase(const bf16_t* z, bf16_t* pooled, int ldp, int gw, int NGW, int lane) {
    for (int it = gw; it < (MTOK / 64) * 2; it += NGW) {
        const int half = it & 1, r0 = (it >> 1) * 64, ch = half * 512 + lane * 8, w = 2 << (ch >> 8), t0 = r0 & (SEQ - 1);
        const bf16_t* zp = z + (size_t)r0 * INW + ch;
        float acc[8];
#pragma unroll
        for (int e = 0; e < 8; ++e) acc[e] = 0.f;
        for (int j = 1; j <= 16; ++j) {
            if (j <= w && t0 - j >= 0) { const u32x4 q = *(const u32x4*)(zp - (size_t)j * INW);
                acc[0] += bf_lo(q.x); acc[1] += bf_hi(q.x); acc[2] += bf_lo(q.y); acc[3] += bf_hi(q.y); acc[4] += bf_lo(q.z); acc[5] += bf_hi(q.z); acc[6] += bf_lo(q.w); acc[7] += bf_hi(q.w); }
        }
        for (int t = 0; t < 64; ++t) {
            const u32x4 q = *(const u32x4*)(zp + (size_t)t * INW);
            float u[8] = {bf_lo(q.x), bf_hi(q.x), bf_lo(q.y), bf_hi(q.y), bf_lo(q.z), bf_hi(q.z), bf_lo(q.w), bf_hi(q.w)};
            const int tt = t0 + t;
            unsigned zz; asm volatile("v_mov_b32 %0, 0" : "=v"(zz)); u32x4 o4 = {zz, zz, zz, zz};
            if (tt - w >= 0) o4 = *(const u32x4*)(zp + (ptrdiff_t)(t - w) * INW);
            const float old[8] = {bf_lo(o4.x), bf_hi(o4.x), bf_lo(o4.y), bf_hi(o4.y), bf_lo(o4.z), bf_hi(o4.z), bf_lo(o4.w), bf_hi(o4.w)};
            const float inv = 1.0f / (float)(tt + 1 < w ? tt + 1 : w);
            float r[8];
#pragma unroll
            for (int e = 0; e < 8; ++e) { acc[e] += u[e] - old[e]; r[e] = acc[e] * inv - u[e]; }
            u32x4 o; o.x = cvt_pk_bf16(r[0], r[1]); o.y = cvt_pk_bf16(r[2], r[3]); o.z = cvt_pk_bf16(r[4], r[5]); o.w = cvt_pk_bf16(r[6], r[7]);
            *(u32x4*)(pooled + (size_t)(r0 + t) * ldp + ch) = o;
        }
    }
}
__device__ __forceinline__ void subln_phase(bf16_t* cat, const float* gsub, float omli, int gw, int NGW, int lane) {
    float gv[16];
#pragma unroll
    for (int e = 0; e < 16; ++e) gv[e] = gsub[(lane & 15) * 16 + e] * omli;
    for (int m = gw; m < MTOK; m += NGW) {
        u32x4* p = (u32x4*)(cat + (size_t)m * LDCAT + lane * 16);
        const u32x4 q0 = p[0], q1 = p[1];
        float v[16] = {bf_lo(q0.x), bf_hi(q0.x), bf_lo(q0.y), bf_hi(q0.y), bf_lo(q0.z), bf_hi(q0.z), bf_lo(q0.w), bf_hi(q0.w),
                       bf_lo(q1.x), bf_hi(q1.x), bf_lo(q1.y), bf_hi(q1.y), bf_lo(q1.z), bf_hi(q1.z), bf_lo(q1.w), bf_hi(q1.w)};
        float s = 0.f;
#pragma unroll
        for (int e = 0; e < 16; ++e) s += v[e] * v[e];
        s += swz<1>(s); s += swz<2>(s); s += swz<4>(s); s += swz<8>(s);
        const float rstd = __builtin_amdgcn_rsqf(s * (1.f / 256.f) + 1e-5f);
#pragma unroll
        for (int e = 0; e < 16; ++e) v[e] = v[e] * rstd * gv[e];
        u32x4 o0, o1;
        o0.x = cvt_pk_bf16(v[0], v[1]); o0.y = cvt_pk_bf16(v[2], v[3]); o0.z = cvt_pk_bf16(v[4], v[5]); o0.w = cvt_pk_bf16(v[6], v[7]);
        o1.x = cvt_pk_bf16(v[8], v[9]); o1.y = cvt_pk_bf16(v[10], v[11]); o1.z = cvt_pk_bf16(v[12], v[13]); o1.w = cvt_pk_bf16(v[14], v[15]);
        p[0] = o0; p[1] = o1;
    }
}
__device__ __forceinline__ void rope_entry(float* cosT, float* sinT, float invf, int idx) {
    {
        const int pos = idx >> 4;
        const float ang = (float)pos * invf;
        double t = (double)ang * 0.15915494309189533577;
        t -= rint(t);
        const double kq = rint(t * 4.0);
        const double y = (t - kq * 0.25) * 6.283185307179586476925;
        const double y2 = y * y;
        double sn = y * (1.0 + y2 * (-1.0 / 6 + y2 * (1.0 / 120 + y2 * (-1.0 / 5040 + y2 * (1.0 / 362880 + y2 * (-1.0 / 39916800 + y2 * (1.0 / 6227020800.0)))))));
        double cs = 1.0 + y2 * (-0.5 + y2 * (1.0 / 24 + y2 * (-1.0 / 720 + y2 * (1.0 / 40320 + y2 * (-1.0 / 3628800 + y2 * (1.0 / 479001600.0 + y2 * (-1.0 / 87178291200.0)))))));
        const int kk = ((int)kq) & 3;
        double c, s;
        if (kk == 0) { c = cs; s = sn; } else if (kk == 1) { c = -sn; s = cs; } else if (kk == 2) { c = -cs; s = -sn; } else { c = sn; s = -cs; }
        cosT[idx] = (float)c; sinT[idx] = (float)s;
    }
}
__device__ __forceinline__ void fold_pool(const float* wp  , const float* sc  , const float* wout  , bf16_t* WT  , int gtid, int ngt) {
    for (int it = gtid; it < 1024 * 128; it += ngt) {
        const int n = (it & 63) | ((it >> 13) << 6), kc = (it >> 6) & 127, g = kc >> 5, kk0 = (kc & 31) * 8;
        const float* wpr = wp + (size_t)g * 65536 + (size_t)kk0 * 256;
        float acc[8];
#pragma unroll
        for (int i = 0; i < 8; ++i) acc[i] = 0.f;
        for (int e = 0; e < 256; ++e) {
            const float wv = wout[(size_t)(g * 256 + e) * DM + n] * sc[g * 256 + e];
#pragma unroll
            for (int i = 0; i < 8; ++i) acc[i] += wpr[i * 256 + e] * wv;
        }
        u32x4 o; o.x = cvt_pk_bf16(acc[0], acc[1]); o.y = cvt_pk_bf16(acc[2], acc[3]); o.z = cvt_pk_bf16(acc[4], acc[5]); o.w = cvt_pk_bf16(acc[6], acc[7]);
        *(u32x4*)(WT + (size_t)n * LDCAT + kc * 8) = o;
    }
}
#define XB_TMO      128
#define XB_XCNT(j)  (256  + 64 * (j))
#define XB_XSUB(j)  (1280 + 64 * (j))
#define XB_XGEN(j)  (2304 + 64 * (j))
#define XB_TOP      3328
#define XB_TOPGEN   3392
#define XCD_BAR_WORDS 3456
#define XB_SPIN_CAP (1u << 18)

__device__ __forceinline__ unsigned xb_ld(unsigned* p)              { return __hip_atomic_load(p, __ATOMIC_RELAXED, __HIP_MEMORY_SCOPE_AGENT); }
__device__ __forceinline__ unsigned xb_add(unsigned* p, unsigned v) { return __hip_atomic_fetch_add(p, v, __ATOMIC_RELAXED, __HIP_MEMORY_SCOPE_AGENT); }
__device__ __forceinline__ unsigned xb_xcc_id() { return (unsigned)__builtin_amdgcn_s_getreg((3 << 11) | 20) & 0xFu; }
#define XB_SPIN(cond, bar) do { unsigned _sp = 0; while (cond) { __builtin_amdgcn_s_sleep(1); \
    if ((++_sp & 255u) == 0u) { if (xb_ld(&(bar)[XB_TMO])) break; if (_sp > XB_SPIN_CAP) { atomicAdd(&(bar)[XB_TMO], 1u); break; } } } } while (0)

struct XcdBarrier {
    unsigned* bar; unsigned x;
    volatile LAS unsigned* st;
};

__device__ __forceinline__ XcdBarrier xcd_barrier_post(unsigned* bar, volatile LAS unsigned* st) {
    XcdBarrier b; b.bar = bar; b.x = xb_xcc_id(); b.st = st;
    if (threadIdx.x == 0) (void)xb_add(&bar[XB_XCNT(b.x)], 1u);
    return b;
}
__device__ __forceinline__ void xcd_barrier_complete(unsigned* bar, unsigned x, unsigned& nloc, unsigned& nx) {
    const unsigned G = gridDim.x * gridDim.y * gridDim.z;
    unsigned sum, cnt, mine, sp = 0u;
    for (;;) {
        sum = 0u; cnt = 0u; mine = 0u;
#pragma unroll
        for (unsigned j = 0; j < 16; ++j) { const unsigned c = xb_ld(&bar[XB_XCNT(j)]); sum += c; cnt += (c > 0u) ? 1u : 0u; mine = (j == x) ? c : mine; }
        if (sum == G) break;
        __builtin_amdgcn_s_sleep(1);
        if ((++sp & 255u) == 0u) { if (xb_ld(&bar[XB_TMO])) break; if (sp > XB_SPIN_CAP) { atomicAdd(&bar[XB_TMO], 1u); break; } }
    }
    nloc = mine > 0u ? mine : 1u; nx = cnt > 0u ? cnt : 1u;
}

__device__ __forceinline__ void xcd_barrier(const XcdBarrier& b) {
    asm volatile("s_waitcnt vmcnt(0)" ::: "memory");
    __syncthreads();
    if (threadIdx.x == 0) {
        unsigned* bar = b.bar;
        __builtin_amdgcn_s_waitcnt(0);
        unsigned nloc = b.st[0], nx = b.st[1];
        if (nloc == 0u) { xcd_barrier_complete(bar, b.x, nloc, nx); b.st[0] = nloc; b.st[1] = nx; }
        const unsigned old = xb_add(&bar[XB_XSUB(b.x)], 1u);
        const unsigned gen = old / nloc;
        if (old + 1u == (gen + 1u) * nloc) {
            __builtin_amdgcn_fence(__ATOMIC_RELEASE, "agent");
            asm volatile("s_waitcnt vmcnt(0)" ::: "memory");
            const unsigned og = xb_add(&bar[XB_TOP], 1u);
            const unsigned tg = og / nx;
            if (og + 1u == (tg + 1u) * nx) xb_add(&bar[XB_TOPGEN], 1u);
            else XB_SPIN(xb_ld(&bar[XB_TOPGEN]) == tg, bar);
            __builtin_amdgcn_fence(__ATOMIC_ACQUIRE, "agent");
            xb_add(&bar[XB_XGEN(b.x)], 1u);
            asm volatile("s_waitcnt vmcnt(0)" ::: "memory");
        } else {
            XB_SPIN(xb_ld(&bar[XB_XGEN(b.x)]) == gen, bar);
            __builtin_amdgcn_fence(__ATOMIC_ACQUIRE, "agent");
            asm volatile("s_waitcnt vmcnt(0)" ::: "memory");
        }
    }
    __syncthreads();
}
struct Args { const float* in[21]; float* out; unsigned char* ws; float invf[16]; float lam_init[2]; int j_lo, j_hi, coop, pad; };
constexpr int NJOBS = 43;
__host__ __device__ inline void job_info(int j, int& layer, int& s, bool& sync) {
    if (j < 11) { layer = 0; s = j; s += (s >= 9); }
    else if (j < 21) { layer = 1; s = j - 11 + 1; s += (s >= 9); }
    else if (j == 21) { layer = 1; s = 15; }
    else if (j < 42) { layer = 2 + (j - 22) / 10; s = (j - 22) % 10 + 1; s += (s >= 9); }
    else { layer = 3; s = 16; }
    sync = !(s == 1 || s == 2 || s == 4 || s == 6 || s == 16 || (s == 5 && layer < 2));
}
__global__ void __launch_bounds__(NTHREADS, 2) fwd_kernel(Args a_) {
#if defined(__HIP_DEVICE_COMPILE__)
    extern __shared__ __attribute__((aligned(16))) unsigned char lds_raw[];
    cg::grid_group grid = cg::this_grid();
    LAS unsigned char* lds = (LAS unsigned char*)lds_raw;
    const int j_lo = a_.j_lo, j_hi = a_.j_hi, coop = a_.coop;
    volatile LAS unsigned* misc = (volatile LAS unsigned*)(lds + LDS_MISC);
    if (threadIdx.x < 16) misc[threadIdx.x] = 0u;
    __syncthreads();
    if (coop) {
        unsigned* bar0 = (unsigned*)(a_.ws + WS_CTL);
        if (blockIdx.x == 0) { for (int u = threadIdx.x; u < XCD_BAR_WORDS; u += NTHREADS) __hip_atomic_store(bar0 + u, 0u, __ATOMIC_RELAXED, __HIP_MEMORY_SCOPE_AGENT);
            __builtin_amdgcn_fence(__ATOMIC_RELEASE, "agent"); asm volatile("s_waitcnt vmcnt(0)" ::: "memory"); }
        grid.sync();
        (void)xcd_barrier_post(bar0, misc);
    }
    if (j_lo == 0) { float* cT = (float*)(a_.ws + WS_ROPE);
        for (int idx = blockIdx.x * NTHREADS + threadIdx.x; idx < SEQ * 16; idx += gridDim.x * NTHREADS) rope_entry(cT, cT + SEQ * 16, a_.invf[idx & 15], idx); }
    for (int j = j_lo; j < j_hi; ++j) {
        int layer, s; bool sync; job_info(j, layer, s, sync);
        typedef const __attribute__((address_space(4))) Args* ArgP;
        ArgP ap = (ArgP)__builtin_amdgcn_kernarg_segment_ptr();
        asm volatile("" : "+s"(ap));
#define AIN(k) (ap->in[k])
        int tid_ = threadIdx.x; asm volatile("" : "+v"(tid_));
        const int tid = tid_, lane = tid & 63, wave = __builtin_amdgcn_readfirstlane(tid >> 6);
        int G_ = gridDim.x, wg_ = blockIdx.x; asm volatile("" : "+s"(G_), "+s"(wg_));
        const int G = G_, wg = wg_, gw = wg * NWAVES + wave, NGW = G * NWAVES;
        unsigned char* ws = ap->ws;
        bf16_t* const CAT = (bf16_t*)(ws + WS_CAT); bf16_t* const Z = (bf16_t*)(ws + WS_Z); bf16_t* const ACT = (bf16_t*)(ws + WS_CAT);
        bf16_t* const KV = (bf16_t*)(ws + WS_KV); bf16_t* const POOLED = KV; bf16_t* const HB = (bf16_t*)(ws + WS_P); bf16_t* const P = (bf16_t*)ap->out;     float* const SSQ = (float*)(ws + WS_SSQ);
        const bool do_prep = (s == 0) || (s == 6 && layer < 3); const int pl = (s == 0) ? layer : layer + 1;
        unsigned char* wsw = ws - (((do_prep ? pl : layer) & 1) ? (WS_WIN - WS_OSCR) : 0);
        bf16_t* const WIN = (bf16_t*)(wsw + WS_WIN); bf16_t* const WOUT = (bf16_t*)(wsw + WS_WOUT); bf16_t* const WGU = (bf16_t*)(wsw + WS_WGU); bf16_t* const WDN = (bf16_t*)(wsw + WS_WDN);
        bf16_t* const WMKV = (bf16_t*)(wsw + WS_WMKV); bf16_t* const WPOOL = (bf16_t*)(ws + WS_WPOOL); bf16_t* const WKV = (bf16_t*)(ws + WS_WKV);
        bf16_t* const MEMN = (bf16_t*)(ws + WS_MEMN); bf16_t* const KM = (bf16_t*)(ws + WS_KM); bf16_t* const VT = (bf16_t*)(ws + WS_VT);
        float* const COST = (float*)(ws + WS_ROPE); float* const SINT = COST + SEQ * 16;
        const float* x = AIN(0); float* out = ap->out;
        bool is_gemm = false;
        pg8::GemmDesc d;
        d.A = nullptr; d.B = nullptr; d.lda = 0; d.ldb = 0; d.K = 0; d.rev = 0; d.sched = 0; d.nM = 0; d.nN = 0; d.cid = wg; d.G = G; d.a_h = 0; d.b_b = 0; d.b_h = 0; d.epi = pg8::EPI_BF16;
        d.O = nullptr; d.ldc = 0; d.col_off = 0; d.col_h = 0; d.rope_limit = 0; d.cosT = COST; d.sinT = SINT; d.colscale = nullptr; d.base = nullptr; d.hb = nullptr; d.ssq_out = nullptr; d.ssq_in = nullptr;
        if (do_prep) {
            LAS float* scr = (LAS float*)(lds + wave * 16384);
            conv_matrix(AIN(2) + (size_t)pl * DM * INW, DM, INW, WIN, DM, 0, AIN(4) + pl * DM, scr, gw, NGW, lane);
            if (pl < 2) { conv_matrix(AIN(3) + (size_t)pl * INW * DM + (size_t)DM * DM, DM, DM, WOUT + DM, LDCAT, 0, nullptr, scr, (gw + NGW / 2) % NGW, NGW, lane);
                fold_pool(AIN(11) + (size_t)pl * 4 * 65536, AIN(12) + pl * DM, AIN(3) + (size_t)pl * INW * DM, WOUT, wg * NTHREADS + tid, G * NTHREADS); }
            else conv_matrix(AIN(3) + (size_t)pl * INW * DM, INW, DM, WOUT, LDCAT, 0, nullptr, scr, (gw + NGW / 2) % NGW, NGW, lane);
            conv_matrix(AIN(6) + (size_t)pl * DM * DFF, DM, DFF, WGU, DM, 1, AIN(5) + pl * DM, scr, gw, NGW, lane);
            conv_matrix(AIN(7) + (size_t)pl * DM * DFF, DM, DFF, WGU, DM, 2, AIN(5) + pl * DM, scr, (gw + NGW / 2) % NGW, NGW, lane);
            conv_matrix(AIN(8) + (size_t)pl * DFF * DM, DFF, DM, WDN, DFF, 0, nullptr, scr, gw, NGW, lane);
            conv_matrix(AIN(10) + (size_t)pl * DM * INW, DM, INW, WMKV, DM, 0, nullptr, scr, (gw + NGW / 2) % NGW, NGW, lane);
            norm_rows(AIN(1), AIN(9) + pl * DM, MEMN, MROWS, gw, NGW, lane);
            if (pl == 0) {
                conv_matrix(AIN(14), DM, INW, WKV, DM, 0, AIN(13), scr, gw, NGW, lane);
                hb_rows(x, HB, SSQ, MTOK, gw, NGW, lane);
            }
        }
        if (s == 0) {
        } else if (s == 1) {
            is_gemm = true; d.A = (const char*)HB; d.lda = DM; d.B = (const char*)WIN; d.ldb = DM; d.K = DM; d.nM = MTOK / 256; d.nN = INW / 256;
            d.O = Z; d.ldc = INW; d.rev = layer >= 1; d.rope_limit = layer >= 2 ? 1024 : 0; d.ssq_in = SSQ + (size_t)(2 * layer) * MTOK * 4;
        } else if (s == 2) {
            is_gemm = true; d.A = (const char*)MEMN; d.lda = DM; d.B = (const char*)WMKV; d.ldb = DM; d.K = DM; d.nM = MROWS / 256; d.nN = 4; d.O = KM; d.ldc = DM;
        } else if (s == 3) {
            is_gemm = true; d.A = (const char*)(WMKV + (size_t)DM * DM); d.lda = DM; d.B = (const char*)MEMN; d.ldb = DM; d.K = DM; d.nM = 4; d.nN = MROWS / 256; d.cid = (wg + G - 32) % G; d.O = VT; d.ldc = MROWS;
        } else if (s == 4) {
            if (layer < 2) pool_phase(Z, CAT, LDCAT, gw, NGW, lane);
            else {
                const int jj = layer - 2;
                const float d1 = wave_sum(AIN(15)[jj * 128 + lane] * AIN(16)[jj * 128 + lane] + AIN(15)[jj * 128 + 64 + lane] * AIN(16)[jj * 128 + 64 + lane]);
                const float d2 = wave_sum(AIN(17)[jj * 128 + lane] * AIN(18)[jj * 128 + lane] + AIN(17)[jj * 128 + 64 + lane] * AIN(18)[jj * 128 + 64 + lane]);
                const float lam = __builtin_amdgcn_exp2f(d1 * 1.4426950408889634f) - __builtin_amdgcn_exp2f(d2 * 1.4426950408889634f) + ap->lam_init[jj];
                att::attn_phase((char*)lds_raw, Z, KV, CAT, lam, wg, G);
            }
        } else if (s == 5) {
            is_gemm = true; d.A = (const char*)(Z + 1024); d.lda = INW; d.a_h = 512; d.B = (const char*)KM; d.ldb = DM; d.b_b = (long)NMEM * DM * 2; d.b_h = 512; d.K = 256; d.sched = 1;
            d.epi = pg8::EPI_SOFTMAX; d.O = P; d.ldc = DM; d.col_h = 256;
        } else if (s == 6) {
            if (layer < 2) { }
            else subln_phase(CAT, AIN(19) + (layer - 2) * 256, 1.0f - ap->lam_init[layer - 2], gw, NGW, lane);
        } else if (s == 7) {
            is_gemm = true; d.A = (const char*)P; d.lda = DM; d.a_h = 512; d.B = (const char*)VT; d.ldb = MROWS; d.b_h = (long)256 * MROWS * 2; d.b_b = 512; d.K = 256; d.sched = 1;
            d.O = CAT; d.ldc = LDCAT; d.col_off = 1024; d.col_h = 256;
        } else if (s == 8) {
            is_gemm = true; d.A = (const char*)CAT; d.lda = LDCAT; d.B = (const char*)WOUT; d.ldb = LDCAT; d.K = INW; d.nM = MTOK / 256; d.nN = 4; d.epi = pg8::EPI_RES;
            d.ldc = DM; d.hb = HB; d.ssq_out = SSQ + (size_t)(1 + 2 * layer) * MTOK * 4;
        } else if (s == 10) {
            is_gemm = true; d.A = (const char*)HB; d.lda = DM; d.B = (const char*)WGU; d.ldb = DM; d.K = DM; d.nM = MTOK / 256; d.nN = 2 * DFF / 256; d.epi = pg8::EPI_SWIGLU; d.rev = 1;
            d.O = ACT; d.ldc = DFF; d.ssq_in = SSQ + (size_t)(1 + 2 * layer) * MTOK * 4;
        } else if (s == 11) {
            is_gemm = true; d.A = (const char*)ACT; d.lda = DFF; d.B = (const char*)WDN; d.ldb = DFF; d.K = DFF; d.nM = MTOK / 256; d.nN = 4; d.epi = pg8::EPI_RES;
            d.ldc = DM; d.hb = HB; d.ssq_out = SSQ + (size_t)(2 + 2 * layer) * MTOK * 4;
        } else if (s == 15) {
            is_gemm = true; d.A = (const char*)HB; d.lda = DM; d.B = (const char*)WKV; d.ldb = DM; d.K = DM; d.nM = MTOK / 256; d.nN = INW / 256; d.O = KV; d.ldc = INW; d.rev = 1; d.rope_limit = 1024; d.ssq_in = SSQ + (size_t)4 * MTOK * 4;
        } else {
            final_rows(HB, out, AIN(20), gw, NGW, lane);
        }
        if (is_gemm) {
            if (d.epi == pg8::EPI_BF16) pg8::gemm_phase<pg8::EPI_BF16>(lds, d);
            else if (d.epi == pg8::EPI_RES) pg8::gemm_phase<pg8::EPI_RES>(lds, d);
            else if (d.epi == pg8::EPI_SWIGLU) pg8::gemm_phase<pg8::EPI_SWIGLU>(lds, d);
            else pg8::gemm_phase<pg8::EPI_SOFTMAX>(lds, d);
        }
#undef AIN
        if (sync && j + 1 < j_hi) { XcdBarrier xb; xb.bar = (unsigned*)(ap->ws + WS_CTL); xb.x = xb_xcc_id(); xb.st = misc; xcd_barrier(xb); }
        else {
            if (s == 5) {
                asm volatile("s_waitcnt vmcnt(0)" ::: "memory"); __syncthreads();
                __builtin_amdgcn_fence(__ATOMIC_ACQUIRE, "agent"); asm volatile("s_waitcnt vmcnt(0)" ::: "memory");
            }
            __syncthreads();
        }
    }
#endif
}

#ifndef MK_COOP
#define MK_COOP 1
#endif
extern "C" void kernel_launch(void* const* d_in, const int* in_sizes, int n_in, void* d_out, int out_size, void* d_ws, size_t ws_size, hipStream_t stream) {
    static int grid = 0;
    if (grid == 0) {
        if (n_in != 21 || in_sizes[0] != MTOK * DM || out_size != MTOK * DM || ws_size < WS_END) { fprintf(stderr, "kernel_launch: unexpected shapes / workspace (n_in %d, ws %zu)\n", n_in, ws_size); grid = -1; return; }
        int dev = 0, cus = 0, per_cu = 0;
        (void)hipGetDevice(&dev); (void)hipDeviceGetAttribute(&cus, hipDeviceAttributeMultiprocessorCount, dev);
        if (hipFuncSetAttribute((const void*)fwd_kernel, hipFuncAttributeMaxDynamicSharedMemorySize, LDS_BYTES) != hipSuccess) { fprintf(stderr, "kernel_launch: hipFuncSetAttribute failed\n"); grid = -1; return; }
        if (hipOccupancyMaxActiveBlocksPerMultiprocessor(&per_cu, (const void*)fwd_kernel, NTHREADS, LDS_BYTES) != hipSuccess || per_cu < 1) { fprintf(stderr, "kernel_launch: occupancy query %d\n", per_cu); per_cu = 1; }
        (void)hipGetLastError();
        if (cus <= 0) cus = 256;
        grid = cus;
    }
    if (grid < 0) return;
    Args a{};
    for (int i = 0; i < 21; ++i) a.in[i] = (const float*)d_in[i];
    a.out = (float*)d_out; a.ws = (unsigned char*)d_ws;
    for (int i = 0; i < 16; ++i) a.invf[i] = (float)std::pow((double)500000.0, -(double)(2 * i) / 32.0);
    a.lam_init[0] = (float)(0.8 - 0.6 * std::exp(-0.3 * 2.0)); a.lam_init[1] = (float)(0.8 - 0.6 * std::exp(-0.3 * 3.0));
#if MK_COOP
    a.j_lo = 0; a.j_hi = NJOBS; a.coop = 1;
    void* params[] = {&a};
    hipError_t e = hipLaunchCooperativeKernel((const void*)fwd_kernel, dim3(grid), dim3(NTHREADS), params, LDS_BYTES, stream);
    if (e != hipSuccess) fprintf(stderr, "kernel_launch: cooperative launch failed: %s (grid %d)\n", hipGetErrorString(e), grid);
#else
    int j0 = 0;
    for (int j = 0; j < NJOBS; ++j) { int layer, s; bool sync; job_info(j, layer, s, sync);
        if (sync || j == NJOBS - 1) { a.j_lo = j0; a.j_hi = j + 1; hipLaunchKernelGGL(fwd_kernel, dim3(grid), dim3(NTHREADS), LDS_BYTES, stream, a); j0 = j + 1; } }
#endif
}
```

```cpp
#include <hip/hip_runtime.h>
#include <hip/hip_cooperative_groups.h>
#include <cstdio>
#include <cstdint>
#include <cmath>
namespace cg = cooperative_groups;

#define LAS __attribute__((address_space(3)))
typedef unsigned short bf16_t;
typedef short bf16x8 __attribute__((ext_vector_type(8)));
typedef short s16x4 __attribute__((ext_vector_type(4)));
typedef float f32x4 __attribute__((ext_vector_type(4)));
typedef float f32x16 __attribute__((ext_vector_type(16)));
typedef unsigned u32x4 __attribute__((ext_vector_type(4)));
typedef unsigned u32x2 __attribute__((ext_vector_type(2)));
typedef float f32x2 __attribute__((ext_vector_type(2)));
template <class A, class Bt> struct same_t { static constexpr bool v = false; };
template <class A> struct same_t<A, A> { static constexpr bool v = true; };

constexpr int DM = 1024, NB = 8, SEQ = 8192, MTOK = NB * SEQ, INW = 2048, DFF = 2816, NMEM = 256, MROWS = NB * NMEM;
constexpr int HALF_M = MTOK / 2;
constexpr size_t MiB = 1u << 20;
constexpr int LDCAT = INW + 64;
constexpr size_t WS_CAT = 0, WS_Z = 264 * MiB, WS_KV = 520 * MiB, WS_P = 776 * MiB, WS_OSCR = 904 * MiB;
constexpr size_t WS_WIN = 936 * MiB, WS_WOUT = 940 * MiB, WS_WGU = 945 * MiB, WS_WDN = 956 * MiB, WS_WMKV = 962 * MiB, WS_WPOOL = 966 * MiB, WS_WKV = 967 * MiB;
constexpr size_t WS_MEMN = 971 * MiB, WS_KM = 975 * MiB, WS_VT = 979 * MiB, WS_ROPE = 983 * MiB, WS_CTL = 984 * MiB, WS_SSQ = 985 * MiB, WS_END = 994 * MiB;
constexpr int LDS_STATS = 131072, LDS_MISC = 131072 + 16384, LDS_BYTES = LDS_MISC + 64;
constexpr int NTHREADS = 512, NWAVES = 8;

__device__ __forceinline__ unsigned cvt_pk_bf16(float lo, float hi) { unsigned r; asm volatile("v_cvt_pk_bf16_f32 %0, %1, %2" : "=v"(r) : "v"(lo), "v"(hi)); return r; }
__device__ __forceinline__ float bf_lo(unsigned w) { return __uint_as_float(w << 16); }
__device__ __forceinline__ float bf_hi(unsigned w) { return __uint_as_float(w & 0xffff0000u); }
template <int X> __device__ __forceinline__ float swz(float v) { return __int_as_float(__builtin_amdgcn_ds_swizzle(__float_as_int(v), (X << 10) | 0x1f)); }
__device__ __forceinline__ float sum32(float v) { auto rr = __builtin_amdgcn_permlane32_swap(__float_as_uint(v), __float_as_uint(v), false, false); return __uint_as_float(rr[0]) + __uint_as_float(rr[1]); }
__device__ __forceinline__ float max32(float v) { auto rr = __builtin_amdgcn_permlane32_swap(__float_as_uint(v), __float_as_uint(v), false, false); return fmaxf(__uint_as_float(rr[0]), __uint_as_float(rr[1])); }
__device__ __forceinline__ float other32(float v, bool upper) { auto rr = __builtin_amdgcn_permlane32_swap(__float_as_uint(v), __float_as_uint(v), false, false); return __uint_as_float(upper ? rr[0] : rr[1]); }
__device__ __forceinline__ float wave_sum(float v) { v += swz<1>(v); v += swz<2>(v); v += swz<4>(v); v += swz<8>(v); v += swz<16>(v); return sum32(v); }

namespace pg8 {
constexpr int BM = 256, BK = 64, HALF = 128, HTB = HALF * BK * 2, STAGE_BYTES = 8 * HTB, NXCD = 8, WGM = 8;
__host__ __device__ __forceinline__ int lds_byte(int r, int c) { const int st = (r >> 4) * 2 + (c >> 5), rr = r & 15, cc = c & 31, ob = rr * 64 + cc * 2; return st * 1024 + (ob ^ (((ob >> 9) & 1) << 5)); }
__host__ __device__ __forceinline__ void stage_rc(int b, int& R, int& C) { const int st = b / 1024, sb = b % 1024, swz = sb ^ (((sb >> 9) & 1) << 5); R = (st >> 1) * 16 + swz / 64; C = (st & 1) * 32 + (swz % 64) / 2; }
__host__ __device__ __forceinline__ int perm32(int rho) { const int n = rho >> 4, i = rho & 15; return 8 * (i >> 2) + 4 * n + (i & 3); }

struct Unit { int pm, pn, b, h; };
enum { EPI_BF16 = 0, EPI_RES = 1, EPI_SWIGLU = 2, EPI_SOFTMAX = 3 };
struct GemmDesc {
    const char* A; const char* B;
    int lda, ldb, K;
    int rev;
    int sched, nM, nN, cid, G;
    long a_h, b_b, b_h;
    int epi;
    void* O; int ldc; int col_off, col_h;
    int rope_limit; const float* cosT; const float* sinT; const float* colscale;
    const float* base;
    bf16_t* hb; float* ssq_out;
    const float* ssq_in;
};
__device__ __forceinline__ bool unit_next(const GemmDesc& d, int i, Unit& u) {
    long L = (long)i * d.G + d.cid;
    if (d.sched == 0) {
        const int nwg = d.nM * d.nN;
        if (d.rev && nwg % d.G == 0) { const int rounds = nwg / d.G; if (i >= rounds) return false; L = (long)(rounds - 1 - i) * d.G + d.cid; }
        if (L >= nwg) return false;
        int wgid = (int)L; { const int q = nwg / NXCD, r = nwg % NXCD, xcd = wgid % NXCD, off = wgid / NXCD; wgid = (xcd < r ? xcd * (q + 1) : r * (q + 1) + (xcd - r) * q) + off; }
        const int nig = WGM * d.nN, gid = wgid / nig, fm = gid * WGM, gsz = (d.nM - fm) < WGM ? (d.nM - fm) : WGM;
        u.pm = fm + ((wgid % nig) % gsz); u.pn = (wgid % nig) / gsz; u.b = 0; u.h = 0; return true;
    } else {
        if (L >= 1024) return false;
        u.pm = (int)(L & 255); u.h = (int)(L >> 8); u.b = u.pm >> 5; u.pn = 0; return true;
    }
}
__device__ __forceinline__ const char* unit_a(const GemmDesc& d, const Unit& u) { return d.A + (size_t)u.pm * 256 * d.lda * 2 + (size_t)u.h * d.a_h; }
__device__ __forceinline__ const char* unit_b(const GemmDesc& d, const Unit& u) { return d.B + (size_t)u.pn * 256 * d.ldb * 2 + (size_t)u.b * d.b_b + (size_t)u.h * d.b_h; }

template <int EPI>
__device__ __forceinline__ void epilogue(const GemmDesc& d, f32x4 (&acc)[2][2][4][2], const Unit& u, int wr, int wc, int fr, int fq, LAS unsigned char* lds, int parity) {
    const int row0 = u.pm * BM + wr * 64 + fr;
    if constexpr (EPI == EPI_BF16) {
        bf16_t* O = (bf16_t*)d.O; const int ldc = d.ldc;
        const int ctile = u.pn * BM, col0 = d.col_off + u.h * d.col_h + ctile + wc * 32 + 8 * fq;
        const bool rope0 = (wc == 0) && (ctile < d.rope_limit), rope1 = (wc == 0) && (ctile + HALF < d.rope_limit);
        const float sgn = fq < 2 ? -1.f : 1.f;
        f32x4 cs[2][2];
#pragma unroll
        for (int bj = 0; bj < 2; ++bj)
#pragma unroll
            for (int n = 0; n < 2; ++n) cs[bj][n] = d.colscale ? *(const f32x4*)(d.colscale + col0 + bj * HALF + 4 * n) : (f32x4){1.f, 1.f, 1.f, 1.f};
#pragma unroll
        for (int ai = 0; ai < 2; ++ai)
#pragma unroll
            for (int m = 0; m < 4; ++m) {
                const int row = row0 + ai * HALF + m * 16; bf16_t* rowp = O + (size_t)row * ldc + col0;
                float rs = 1.f; if (d.ssq_in) { const f32x4 pr = *(const LAS f32x4*)(lds + LDS_STATS + parity * 4096 + (ai * HALF + wr * 64 + m * 16 + fr) * 16); rs = __builtin_amdgcn_rsqf(((pr[0] + pr[1]) + (pr[2] + pr[3])) * (1.f / DM) + 1e-6f); }
                f32x4 c0 = {1.f, 1.f, 1.f, 1.f}, c1 = c0, s0 = {0.f, 0.f, 0.f, 0.f}, s1 = s0;
                if (rope0 || rope1) { const int pos = row & (SEQ - 1); const float* cp = d.cosT + pos * 16 + 8 * (fq & 1); const float* sp = d.sinT + pos * 16 + 8 * (fq & 1);
                    c0 = *(const f32x4*)cp; c1 = *(const f32x4*)(cp + 4); s0 = *(const f32x4*)sp; s1 = *(const f32x4*)(sp + 4); }
#pragma unroll
                for (int bj = 0; bj < 2; ++bj) { f32x4 v0 = acc[ai][bj][m][0] * rs, v1 = acc[ai][bj][m][1] * rs;
                    if (bj == 0 ? rope0 : rope1) {
#pragma unroll
                        for (int e = 0; e < 4; ++e) { const float p0 = other32(v0[e], fq >= 2), p1 = other32(v1[e], fq >= 2);
                            v0[e] = v0[e] * c0[e] + sgn * p0 * s0[e]; v1[e] = v1[e] * c1[e] + sgn * p1 * s1[e]; } }
                    v0 = v0 * cs[bj][0]; v1 = v1 * cs[bj][1];
                    u32x4 w; w.x = cvt_pk_bf16(v0[0], v0[1]); w.y = cvt_pk_bf16(v0[2], v0[3]); w.z = cvt_pk_bf16(v1[0], v1[1]); w.w = cvt_pk_bf16(v1[2], v1[3]);
                    *(u32x4*)(rowp + bj * HALF) = w; } }
    } else if constexpr (EPI == EPI_RES) {
        bf16_t* HBp = d.hb; float* ssq = d.ssq_out; const int ldc = d.ldc;
        LAS float* stp = (LAS float*)(lds + LDS_STATS + parity * 8192);
        const int col0 = u.pn * BM + wc * 32 + 8 * fq;
#pragma unroll
        for (int ai = 0; ai < 2; ++ai)
#pragma unroll
            for (int m = 0; m < 4; ++m) { const int row = row0 + ai * HALF + m * 16; bf16_t* rowp = HBp + (size_t)row * ldc + col0; float ss = 0.f;
#pragma unroll
                for (int bj = 0; bj < 2; ++bj) { const u32x4 q = *(const u32x4*)(rowp + bj * HALF); const f32x4 a0 = acc[ai][bj][m][0], a1 = acc[ai][bj][m][1];
                    u32x4 w; w.x = cvt_pk_bf16(bf_lo(q.x) + a0[0], bf_hi(q.x) + a0[1]); w.y = cvt_pk_bf16(bf_lo(q.y) + a0[2], bf_hi(q.y) + a0[3]);
                    w.z = cvt_pk_bf16(bf_lo(q.z) + a1[0], bf_hi(q.z) + a1[1]); w.w = cvt_pk_bf16(bf_lo(q.w) + a1[2], bf_hi(q.w) + a1[3]);
                    *(u32x4*)(rowp + bj * HALF) = w;
                    const float h0 = bf_lo(w.x), h1 = bf_hi(w.x), h2 = bf_lo(w.y), h3 = bf_hi(w.y), h4 = bf_lo(w.z), h5 = bf_hi(w.z), h6 = bf_lo(w.w), h7 = bf_hi(w.w);
                    ss += ((h0 * h0 + h1 * h1) + (h2 * h2 + h3 * h3)) + ((h4 * h4 + h5 * h5) + (h6 * h6 + h7 * h7)); }
                ss += swz<16>(ss); ss = sum32(ss);
                if (fq == 0) stp[(ai * HALF + wr * 64 + m * 16 + fr) * 4 + wc] = ss;
                if (m & 1) asm volatile("" ::: "memory"); }
        asm volatile("s_waitcnt lgkmcnt(0)" ::: "memory"); __builtin_amdgcn_s_barrier(); asm volatile("" ::: "memory");
        if (wc == 0 && fq == 0) {
#pragma unroll
            for (int ai = 0; ai < 2; ++ai)
#pragma unroll
                for (int m = 0; m < 4; ++m) { const int rl = ai * HALF + wr * 64 + m * 16 + fr; const LAS float* q = stp + rl * 4;
                    ssq[(size_t)(u.pm * BM + rl) * 4 + u.pn] = (q[0] + q[1]) + (q[2] + q[3]); }
        }
    } else if constexpr (EPI == EPI_SWIGLU) {
        bf16_t* O = (bf16_t*)d.O; const int ldc = d.ldc;
        const int col0 = u.pn * HALF + wc * 32 + 8 * fq;
#pragma unroll
        for (int ai = 0; ai < 2; ++ai)
#pragma unroll
            for (int m = 0; m < 4; ++m) { const int row = row0 + ai * HALF + m * 16; bf16_t* rowp = O + (size_t)row * ldc + col0; float r[8];
                const f32x4 pr = *(const LAS f32x4*)(lds + LDS_STATS + parity * 4096 + (ai * HALF + wr * 64 + m * 16 + fr) * 16); const float rs = __builtin_amdgcn_rsqf(((pr[0] + pr[1]) + (pr[2] + pr[3])) * (1.f / DM) + 1e-6f);
#pragma unroll
                for (int n = 0; n < 2; ++n)
#pragma unroll
                    for (int e = 0; e < 4; ++e) { const float g = acc[ai][0][m][n][e] * rs, up = acc[ai][1][m][n][e] * rs;
                        r[n * 4 + e] = g * __builtin_amdgcn_rcpf(1.f + __builtin_amdgcn_exp2f(-1.4426950408889634f * g)) * up; }
                u32x4 w; w.x = cvt_pk_bf16(r[0], r[1]); w.y = cvt_pk_bf16(r[2], r[3]); w.z = cvt_pk_bf16(r[4], r[5]); w.w = cvt_pk_bf16(r[6], r[7]);
                *(u32x4*)rowp = w; }
    } else {
        bf16_t* O = (bf16_t*)d.O; const int ldc = d.ldc;
        const int col0 = d.col_off + u.h * d.col_h + wc * 32 + 8 * fq;
        constexpr float C = 1.4426950408889634f * 0.0625f;
        LAS f32x2* st = (LAS f32x2*)(lds + LDS_STATS + parity * 8192);
        float mw[2][4];
#pragma unroll
        for (int ai = 0; ai < 2; ++ai)
#pragma unroll
            for (int m = 0; m < 4; ++m) {
                float mx = -3.0e38f;
#pragma unroll
                for (int bj = 0; bj < 2; ++bj)
#pragma unroll
                    for (int n = 0; n < 2; ++n) { const f32x4 x = acc[ai][bj][m][n]; mx = fmaxf(mx, fmaxf(fmaxf(x[0], x[1]), fmaxf(x[2], x[3]))); }
                mx = fmaxf(mx, swz<16>(mx)); mx = max32(mx);
                float s = 0.f;
#pragma unroll
                for (int bj = 0; bj < 2; ++bj)
#pragma unroll
                    for (int n = 0; n < 2; ++n) { f32x4 x = acc[ai][bj][m][n];
#pragma unroll
                        for (int e = 0; e < 4; ++e) { x[e] = __builtin_amdgcn_exp2f((x[e] - mx) * C); s += x[e]; }
                        acc[ai][bj][m][n] = x; }
                s += swz<16>(s); s = sum32(s);
                mw[ai][m] = mx;
                if (fq == 0) st[(ai * HALF + wr * 64 + m * 16 + fr) * 4 + wc] = (f32x2){mx, s};
            }
        asm volatile("s_waitcnt lgkmcnt(0)" ::: "memory"); __builtin_amdgcn_s_barrier(); asm volatile("" ::: "memory");
#pragma unroll
        for (int ai = 0; ai < 2; ++ai)
#pragma unroll
            for (int m = 0; m < 4; ++m) {
                const int rl = ai * HALF + wr * 64 + m * 16 + fr;
                const f32x2 a = st[rl * 4 + 0], b = st[rl * 4 + 1], c = st[rl * 4 + 2], e4 = st[rl * 4 + 3];
                const float M = fmaxf(fmaxf(a.x, b.x), fmaxf(c.x, e4.x));
                const float S = a.y * __builtin_amdgcn_exp2f((a.x - M) * C) + b.y * __builtin_amdgcn_exp2f((b.x - M) * C) + c.y * __builtin_amdgcn_exp2f((c.x - M) * C) + e4.y * __builtin_amdgcn_exp2f((e4.x - M) * C);
                const float f = __builtin_amdgcn_exp2f((mw[ai][m] - M) * C) / S;
                bf16_t* rowp = O + (size_t)(u.pm * BM + rl) * ldc + col0;
#pragma unroll
                for (int bj = 0; bj < 2; ++bj) { const f32x4 v0 = acc[ai][bj][m][0] * f, v1 = acc[ai][bj][m][1] * f;
                    u32x4 w; w.x = cvt_pk_bf16(v0[0], v0[1]); w.y = cvt_pk_bf16(v0[2], v0[3]); w.z = cvt_pk_bf16(v1[0], v1[1]); w.w = cvt_pk_bf16(v1[2], v1[3]);
                    *(u32x4*)(rowp + bj * HALF) = w; } }
    }
}
#ifndef PG8_ALIGN_ALL
#define PG8_ALIGN_ALL true
#endif
template <int EPI>
__device__ __forceinline__ void gemm_phase(LAS unsigned char* lds, const GemmDesc& g) {
    int tid_ = threadIdx.x; asm volatile("" : "+v"(tid_));
    const int tid = tid_, wid = __builtin_amdgcn_readfirstlane(tid >> 6), lane = tid & 63, wr = wid >> 2, wc = wid & 3, fr = lane & 15, fq = lane >> 4;
    const int K = g.K, nt = K / BK;
    constexpr bool perm = true;
    unsigned voffA[2], voffB[2];
#pragma unroll
    for (int i = 0; i < 2; ++i) { int R, C; stage_rc(tid * 16 + i * 8192, R, C); const int Rb = perm ? ((R & ~31) + perm32(R & 31)) : R;
        voffA[i] = (unsigned)(R * g.lda + C) * 2u; voffB[i] = (unsigned)(Rb * g.ldb + C) * 2u; }
    const size_t kstep = (size_t)(BK * 2);
    const size_t hstepA = (size_t)HALF * g.lda * 2, hstepB = (size_t)HALF * g.ldb * 2;
    const unsigned ldsw = (unsigned)wid * 1024u;
    const int aoff = lds_byte(wr * 64 + fr, fq * 8), boff = lds_byte(wc * 32 + fr, fq * 8);
#define PG8_SA(b, h) (((b) * 2 + (h)) * HTB)
#define PG8_SB(b, h) ((4 + (b) * 2 + (h)) * HTB)
#define PG8_STAGE(bufoff, gbase, voff) do { _Pragma("unroll") for (int _i = 0; _i < 2; ++_i) \
        __builtin_amdgcn_global_load_lds((const unsigned*)((const char*)(gbase) + (voff)[_i]), (LAS unsigned*)(lds + (bufoff) + ldsw + _i * 8192), 16, 0, 0); } while (0)
#define PG8_LDA(dst, b, h) do { _Pragma("unroll") for (int m = 0; m < 4; ++m) _Pragma("unroll") for (int k = 0; k < 2; ++k) dst[m][k] = *(const LAS bf16x8*)(lds + PG8_SA(b, h) + aoff + m * 2048 + k * 1024); } while (0)
#define PG8_LDB(dst, b, h) do { _Pragma("unroll") for (int n = 0; n < 2; ++n) _Pragma("unroll") for (int k = 0; k < 2; ++k) dst[n][k] = *(const LAS bf16x8*)(lds + PG8_SB(b, h) + boff + n * 2048 + k * 1024); } while (0)
#define PG8_MMA(ai, bj, At, Bt) do { __builtin_amdgcn_s_setprio(1); _Pragma("unroll") for (int m = 0; m < 4; ++m) _Pragma("unroll") for (int n = 0; n < 2; ++n) _Pragma("unroll") for (int k = 0; k < 2; ++k) \
        acc[ai][bj][m][n] = __builtin_amdgcn_mfma_f32_16x16x32_bf16(Bt[n][k], At[m][k], acc[ai][bj][m][n], 0, 0, 0); __builtin_amdgcn_s_setprio(0); } while (0)
#define PG8_WAIT_V(n) asm volatile("s_waitcnt vmcnt(" #n ")" ::: "memory")
#define PG8_WAIT_L(n) asm volatile("s_waitcnt lgkmcnt(" #n ")" ::: "memory")
#define PG8_BAR __builtin_amdgcn_s_barrier()
#define PG8_SCHED __builtin_amdgcn_sched_barrier(0)
    const bool has_rs = (EPI == EPI_BF16 || EPI == EPI_SWIGLU) && g.ssq_in != nullptr;
#define PG8_ELOAD(un, par) do { if (has_rs && wid < 4) __builtin_amdgcn_global_load_lds((const unsigned*)(g.ssq_in + ((size_t)(un).pm * 256 + wid * 64 + lane) * 4), (LAS unsigned*)(lds + LDS_STATS + (par) * 4096 + wid * 1024), 16, 0, 0); } while (0)
    Unit cur, nxt; int ui = 0;
    if (!unit_next(g, 0, cur)) return;
    f32x4 acc[2][2][4][2];
    float z0; asm volatile("v_mov_b32 %0, 0" : "=v"(z0));
#pragma unroll
    for (int a = 0; a < 2; ++a)
#pragma unroll
        for (int b = 0; b < 2; ++b)
#pragma unroll
            for (int m = 0; m < 4; ++m)
#pragma unroll
                for (int n = 0; n < 2; ++n) acc[a][b][m][n] = (f32x4){z0, z0, z0, z0};
    bf16x8 At[4][2], B0[2][2], B1[2][2];
    const char* cA = unit_a(g, cur); const char* cB = unit_b(g, cur);
    PG8_ELOAD(cur, 0);
    PG8_STAGE(PG8_SB(0, 0), cB, voffB); PG8_STAGE(PG8_SB(0, 1), cB + hstepB, voffB); PG8_STAGE(PG8_SA(0, 0), cA, voffA); PG8_STAGE(PG8_SA(0, 1), cA + hstepA, voffA);
    if (wr == 1) PG8_BAR;
    PG8_WAIT_V(2); PG8_BAR;
    PG8_STAGE(PG8_SB(1, 0), cB + kstep, voffB); PG8_STAGE(PG8_SA(1, 0), cA + kstep, voffA); PG8_STAGE(PG8_SB(1, 1), cB + hstepB + kstep, voffB);
    PG8_WAIT_V(6); PG8_BAR;
    for (;;) {
        const bool has_next = unit_next(g, ui + 1, nxt);
        const char* nA = has_next ? unit_a(g, nxt) : cA; const char* nB = has_next ? unit_b(g, nxt) : cB;
        for (int t = 0; t < nt; t += 2) {
            const bool last = (t == nt - 2);
            const char* a1 = cA + (size_t)(t + 1) * kstep;
            const char* a2 = last ? nA : cA + (size_t)(t + 2) * kstep; const char* b2 = last ? nB : cB + (size_t)(t + 2) * kstep;
            const char* a3 = a2 + kstep; const char* b3 = b2 + kstep;
            if (last && has_next) PG8_ELOAD(nxt, (ui + 1) & 1);
            PG8_LDB(B0, 0, 0); PG8_LDB(B1, 0, 1); PG8_SCHED; PG8_LDA(At, 0, 0); PG8_STAGE(PG8_SA(1, 1), a1 + hstepA, voffA);
            PG8_WAIT_V(8); PG8_WAIT_L(0); PG8_BAR; PG8_MMA(0, 0, At, B0); PG8_MMA(0, 1, At, B1); PG8_BAR; PG8_SCHED;
            PG8_LDA(At, 0, 1); PG8_STAGE(PG8_SB(0, 0), b2, voffB); PG8_STAGE(PG8_SB(0, 1), b2 + hstepB, voffB); PG8_STAGE(PG8_SA(0, 0), a2, voffA);
            PG8_WAIT_V(8); PG8_WAIT_L(0); PG8_BAR; PG8_MMA(1, 0, At, B0); PG8_MMA(1, 1, At, B1); PG8_BAR; PG8_SCHED;
            PG8_LDB(B0, 1, 0); PG8_LDB(B1, 1, 1); PG8_SCHED; PG8_LDA(At, 1, 0); PG8_STAGE(PG8_SA(0, 1), a2 + hstepA, voffA);
            PG8_WAIT_V(8); PG8_WAIT_L(0); PG8_BAR; PG8_MMA(0, 0, At, B0); PG8_MMA(0, 1, At, B1); PG8_BAR; PG8_SCHED;
            PG8_LDA(At, 1, 1); PG8_STAGE(PG8_SB(1, 0), b3, voffB); PG8_STAGE(PG8_SB(1, 1), b3 + hstepB, voffB); PG8_STAGE(PG8_SA(1, 0), a3, voffA);
            PG8_WAIT_V(8); PG8_WAIT_L(0); PG8_BAR; PG8_MMA(1, 0, At, B0); PG8_MMA(1, 1, At, B1); PG8_BAR; PG8_SCHED;
        }
        constexpr bool ALIGN = (EPI == EPI_RES || EPI == EPI_SOFTMAX) || PG8_ALIGN_ALL;
        if (ALIGN) { if (wr == 0) PG8_BAR; }
        epilogue<EPI>(g, acc, cur, wr, wc, fr, fq, lds, ui & 1);
        if (!has_next) break;
        float z1; asm volatile("v_mov_b32 %0, 0" : "=v"(z1));
#pragma unroll
        for (int a = 0; a < 2; ++a)
#pragma unroll
            for (int b = 0; b < 2; ++b)
#pragma unroll
                for (int m = 0; m < 4; ++m)
#pragma unroll
                    for (int n = 0; n < 2; ++n) acc[a][b][m][n] = (f32x4){z1, z1, z1, z1};
        cur = nxt; cA = nA; cB = nB; ++ui;
        if (ALIGN) { if (wr == 1) PG8_BAR; }
    }
    PG8_WAIT_V(0);
    if (!((EPI == EPI_RES || EPI == EPI_SOFTMAX) || PG8_ALIGN_ALL)) { if (wr == 0) PG8_BAR; }
    PG8_BAR;
#undef PG8_SA
#undef PG8_SB
#undef PG8_STAGE
#undef PG8_LDA
#undef PG8_LDB
#undef PG8_MMA
#undef PG8_WAIT_V
#undef PG8_WAIT_L
#undef PG8_BAR
#undef PG8_SCHED
#undef PG8_ELOAD
}
}
namespace att {
constexpr int D = 128, LDQ = 2048, LDKV = 2048, LDO = LDCAT;
constexpr float SCALE = 0.08838834764831845f;
constexpr float THR = 8.f;
constexpr bool WSKIP = false;
constexpr int NW = 8, QBLK = 32, KVBLK = 64, QB = NW * QBLK;
constexpr int SHM_V = KVBLK * D * 2, SHM_K = KVBLK * D * 2;
constexpr int ATT_LDS_BYTES = 2 * SHM_V + 2 * SHM_K + NW * 64 * 4;
#define KSWZ(row, colB) ((row) * 256 + ((colB) ^ (((row) & 7) << 4)))
#define SBAR() __builtin_amdgcn_sched_barrier(0)
__device__ __forceinline__ int v_st(int k, int c) { const int kk = (k & ~0xC) | ((k & 4) << 1) | ((k & 8) >> 1); return ((kk >> 3) * 4 + (c >> 5)) * 512 + ((kk & 7) * 32 + (c & 31)) * 2; }
__device__ __forceinline__ int v_rd_base(int lane) { return ((lane & 3) << 3) | (((lane >> 2) & 3) << 6) | (((lane >> 4) & 1) << 5) | (((lane >> 5) & 1) << 8); }
constexpr int v_rd_off(int d0, int ks, int half) { return d0 * 512 + ks * 4096 + half * 2048; }
__device__ __forceinline__ int crow(int r, int hi) { return (r & 3) + 8 * (r >> 2) + 4 * hi; }
__device__ __forceinline__ unsigned cvtpk(float lo, float hi) {
    unsigned r; asm volatile("v_cvt_pk_bf16_f32 %0, %1, %2" : "=v"(r) : "v"(lo), "v"(hi)); return r;
}
__device__ __forceinline__ bf16x8 pack8(f32x4 a, f32x4 b) {
    u32x4 w = {cvtpk(a[0], a[1]), cvtpk(a[2], a[3]), cvtpk(b[0], b[1]), cvtpk(b[2], b[3])};
    return *reinterpret_cast<bf16x8*>(&w);
}
template <class T> __device__ __forceinline__ bf16x8 load8(const T* p) {
    if constexpr (same_t<T, float>::v) { return pack8(*(const f32x4*)p, *(const f32x4*)(p + 4)); }
    else { return *reinterpret_cast<const bf16x8*>(p); }
}
__device__ __forceinline__ void mask_tile(f32x16& p0, f32x16& p1, int dq, unsigned W) {
    const float NEG = -__builtin_inff();
#pragma unroll
    for (int r = 0; r < 16; ++r) {
        const int c = (r & 3) + 8 * (r >> 2);
        if ((unsigned)(dq - c) >= W) p0[r] = NEG;
        if ((unsigned)(dq - c - 32) >= W) p1[r] = NEG;
    }
}
__device__ __forceinline__ void partialSM(f32x16& p0, f32x16& p1, float& m_reg, float& mn, float& alpha) {
    float pmax = p0[0]; for (int r = 1; r < 16; ++r) pmax = fmaxf(pmax, p0[r]); for (int r = 0; r < 16; ++r) pmax = fmaxf(pmax, p1[r]);
    { auto rr = __builtin_amdgcn_permlane32_swap(__float_as_uint(pmax), __float_as_uint(pmax), false, false);
      pmax = fmaxf(__uint_as_float(rr[0]), __uint_as_float(rr[1])); }
    constexpr float C2 = 1.4426950408889634f * SCALE;
    if (__builtin_expect(__all((pmax - m_reg) * SCALE <= THR), 1)) { mn = m_reg; alpha = 1.f; }
    else { mn = fmaxf(m_reg, pmax); alpha = __builtin_amdgcn_exp2f((m_reg - mn) * C2); m_reg = mn; }
    const float mnL = -mn * C2;
    for (int r = 0; r < 16; ++r) p0[r] = fmaf(p0[r], C2, mnL); for (int r = 0; r < 16; ++r) p1[r] = fmaf(p1[r], C2, mnL);
    for (int r = 0; r < 16; ++r) p0[r] = __builtin_amdgcn_exp2f(p0[r]);
}
__device__ __forceinline__ void finishSM(f32x16& p0, f32x16& p1, float alpha, float& l_reg, bf16x8& pa0, bf16x8& pa1, bf16x8& pa2, bf16x8& pa3) {
    for (int r = 0; r < 16; ++r) p1[r] = __builtin_amdgcn_exp2f(p1[r]);
    float ps = 0; for (int r = 0; r < 16; ++r) ps += p0[r]; for (int r = 0; r < 16; ++r) ps += p1[r];
    { auto rr = __builtin_amdgcn_permlane32_swap(__float_as_uint(ps), __float_as_uint(ps), false, false);
      ps = __uint_as_float(rr[0]) + __uint_as_float(rr[1]); }
    l_reg = l_reg * alpha + ps;
#define PK4(P, B_, OUT) do { unsigned a0 = cvtpk(P[B_+0], P[B_+1]), a1 = cvtpk(P[B_+2], P[B_+3]);                          \
        unsigned b0 = cvtpk(P[B_+4], P[B_+5]), b1 = cvtpk(P[B_+6], P[B_+7]);                                             \
        auto r0 = __builtin_amdgcn_permlane32_swap(a0, b0, false, false); auto r1 = __builtin_amdgcn_permlane32_swap(a1, b1, false, false); \
        u32x4 w = {r0[0], r1[0], r0[1], r1[1]}; OUT = *reinterpret_cast<bf16x8*>(&w); } while (0)
    PK4(p0, 0, pa0); PK4(p0, 8, pa1); PK4(p1, 0, pa2); PK4(p1, 8, pa3);
#undef PK4
}
template <int KB, bool SK>
__device__ __forceinline__ void qkt(f32x16& p0, f32x16& p1, const char* K_lds, int r32, int hi, const bf16x8* qr, bool act) {
    if (SK && !act) { const float NEG = -__builtin_inff();
#pragma unroll
        for (int r = 0; r < 16; ++r) { p0[r] = NEG; p1[r] = NEG; } return; }
    p0 = f32x16{}; p1 = f32x16{};
    const char* kb[4];
#pragma unroll
    for (int dd = 0; dd < 4; ++dd) kb[dd] = K_lds + KB * SHM_K + KSWZ(r32, (dd * 16 + hi * 8) * 2);
#pragma unroll
    for (int d0 = 0; d0 < 8; ++d0) { const char* a = kb[d0 & 3] + (d0 >> 2) * 128;
        bf16x8 b0 = *reinterpret_cast<const bf16x8*>(a);
        bf16x8 b1 = *reinterpret_cast<const bf16x8*>(a + 32 * 256);
        p0 = __builtin_amdgcn_mfma_f32_32x32x16_bf16(b0, qr[d0], p0, 0, 0, 0);
        p1 = __builtin_amdgcn_mfma_f32_32x32x16_bf16(b1, qr[d0], p1, 0, 0, 0); }
}
template <int VB, bool SK>
__device__ __forceinline__ void pv_tile(f32x16* o, int vb0, bf16x8 pa0, bf16x8 pa1, bf16x8 pa2, bf16x8 pa3, bool act) {
    if (SK && !act) return;
#define TRRD(dst, off) asm volatile("ds_read_b64_tr_b16 %0, %1 offset:%2" : "=&v"(dst) : "v"(vb0), "i"(off) : "memory")
#define PV_D0(d0) do { s16x4 l0, l1, l2, l3, h0, h1, h2, h3; constexpr int b_ = VB * SHM_V + v_rd_off(d0, 0, 0);     \
        TRRD(l0, b_); TRRD(h0, b_ + 2048); TRRD(l1, b_ + 4096); TRRD(h1, b_ + 6144); TRRD(l2, b_ + 8192); TRRD(h2, b_ + 10240); TRRD(l3, b_ + 12288); TRRD(h3, b_ + 14336); \
        asm volatile("s_waitcnt lgkmcnt(0)" ::: "memory"); SBAR();                 \
        o[d0] = __builtin_amdgcn_mfma_f32_32x32x16_bf16(pa0, (bf16x8){l0[0], l0[1], l0[2], l0[3], h0[0], h0[1], h0[2], h0[3]}, o[d0], 0, 0, 0);   \
        o[d0] = __builtin_amdgcn_mfma_f32_32x32x16_bf16(pa1, (bf16x8){l1[0], l1[1], l1[2], l1[3], h1[0], h1[1], h1[2], h1[3]}, o[d0], 0, 0, 0);   \
        o[d0] = __builtin_amdgcn_mfma_f32_32x32x16_bf16(pa2, (bf16x8){l2[0], l2[1], l2[2], l2[3], h2[0], h2[1], h2[2], h2[3]}, o[d0], 0, 0, 0);   \
        o[d0] = __builtin_amdgcn_mfma_f32_32x32x16_bf16(pa3, (bf16x8){l3[0], l3[1], l3[2], l3[3], h3[0], h3[1], h3[2], h3[3]}, o[d0], 0, 0, 0); } while (0)
    PV_D0(0); PV_D0(1); PV_D0(2); PV_D0(3);
#undef PV_D0
#undef TRRD
}

template <class TIn, class TOut> struct BlockRef { const TIn* Q; const TIn* K; const TIn* V; TOut* O; int P0; int mode; };
template <class TIn> struct Seam {
    bf16x8 qr[8];
    bf16x8 st_v0, st_v1, st_k0, st_k1; f32x4 sf0, sf1, sf2, sf3;
    f32x4 tq[16];
};
__device__ __forceinline__ int swa_jlo(int P0, int W) { const int lowk = P0 - W + 1; return lowk > 0 ? lowk / KVBLK : 0; }
#define ROW(p, k0, rr) ((p) + (size_t)((k0) + (rr)) * LDKV + sc)
#define VMW() asm volatile("s_waitcnt vmcnt(0)" ::: "memory")
#define VMWN(n) asm volatile("s_waitcnt vmcnt(%0)" :: "i"(n) : "memory")
#define SLOAD_H(Kp, Vp, k0) do { S.st_v0 = load8<TIn>(ROW(Vp, k0, sr)); S.st_v1 = load8<TIn>(ROW(Vp, k0, 32 + sr));              \
                         S.st_k0 = load8<TIn>(ROW(Kp, k0, sr)); S.st_k1 = load8<TIn>(ROW(Kp, k0, 32 + sr)); } while (0)
#define SWRITE_HK(bf) do { *(bf16x8*)(K_lds + (bf) * SHM_K + kws) = S.st_k0; *(bf16x8*)(K_lds + (bf) * SHM_K + kws + 32 * 256) = S.st_k1; } while (0)
#define SWRITE_HV(bf) do { *(bf16x8*)(V_lds + (bf) * SHM_V + vst0) = S.st_v0; *(bf16x8*)(V_lds + (bf) * SHM_V + vst1) = S.st_v1; } while (0)
#define SWRITE_H(bf) do { SWRITE_HV(bf); SWRITE_HK(bf); } while (0)
#define SLOAD_F(p, k0) do { S.sf0 = *(const f32x4*)ROW(p, k0, sr); S.sf1 = *(const f32x4*)(ROW(p, k0, sr) + 4);                \
                            S.sf2 = *(const f32x4*)ROW(p, k0, 32 + sr); S.sf3 = *(const f32x4*)(ROW(p, k0, 32 + sr) + 4); } while (0)
#define SWRITE_KF(bf) do { *(bf16x8*)(K_lds + (bf) * SHM_K + kws) = pack8(S.sf0, S.sf1); *(bf16x8*)(K_lds + (bf) * SHM_K + kws + 32 * 256) = pack8(S.sf2, S.sf3); } while (0)
#define SWRITE_VF(bf) do { *(bf16x8*)(V_lds + (bf) * SHM_V + vst0) = pack8(S.sf0, S.sf1); *(bf16x8*)(V_lds + (bf) * SHM_V + vst1) = pack8(S.sf2, S.sf3); } while (0)
template <class TIn, class TOut>
__device__ __forceinline__ void causal_swa_prime(const BlockRef<TIn, TOut>& cur, int W, char* lds, Seam<TIn>& S) {
    constexpr bool F32 = same_t<TIn, float>::v;
    int tid_ = threadIdx.x; asm volatile("" : "+v"(tid_));
    const int tid = tid_, wid = __builtin_amdgcn_readfirstlane(tid >> 6), lane = tid & 63, r32 = lane & 31, hi = lane >> 5;
    const int sr = tid >> 4, sc = (tid & 15) * 8, kws = KSWZ(sr, sc * 2); char* K_lds = lds + 2 * SHM_V;
    const int kb0 = swa_jlo(cur.P0, W) * KVBLK;
    for (int d0 = 0; d0 < 8; ++d0) S.qr[d0] = load8<TIn>(cur.Q + (size_t)(wid * QBLK + r32) * LDQ + d0 * 16 + hi * 8);
    if constexpr (F32) { SLOAD_F((const float*)cur.K, kb0); VMW(); SWRITE_KF(0); SBAR(); SLOAD_F((const float*)cur.V, kb0); }
    else { SLOAD_H(cur.K, cur.V, kb0); VMW(); SWRITE_HK(0); }
    __syncthreads();
}
template <class TIn, class TOut>
__device__ __forceinline__ void causal_swa_block(const BlockRef<TIn, TOut>& cur, const BlockRef<TIn, TOut>& nxt, int skv, int W, char* lds, Seam<TIn>& S, float lam) {
    constexpr bool F32 = same_t<TIn, float>::v;
    int tid_ = threadIdx.x; asm volatile("" : "+v"(tid_));
    const int tid = tid_, wid = __builtin_amdgcn_readfirstlane(tid >> 6), lane = tid & 63, r32 = lane & 31, hi = lane >> 5;
    const int j_lo = swa_jlo(cur.P0, W);
    int j_hi = (cur.P0 + QB - 1) / KVBLK + 1; if (j_hi > skv / KVBLK) j_hi = skv / KVBLK;
    const int NT = j_hi - j_lo;
    const int kbn = swa_jlo(nxt.P0, W) * KVBLK;
    const int qlo = cur.P0 + wid * QBLK, qm = qlo + r32 - 4 * hi;
    char* V_lds = lds; char* K_lds = lds + 2 * SHM_V;
    float* ws = (float*)(lds + 2 * SHM_V + 2 * SHM_K) + wid * 64; float* li_l = ws, * al_l = ws + 32;
    float m_reg = -1e30f, l_reg = 0; f32x16 o[4] = {};
    const int sr = tid >> 4, sc = (tid & 15) * 8, vst0 = v_st(sr, sc), vst1 = v_st(32 + sr, sc), kws = KSWZ(sr, sc * 2);
    const int vb0 = (int)(uintptr_t)V_lds + v_rd_base(lane);
    const TIn* Kh = cur.K; const TIn* Vh = cur.V;
#define RESC(a) do { if (__any((a) < 1.f)) { if (hi == 0) al_l[r32] = (a); asm volatile("s_waitcnt lgkmcnt(0)" ::: "memory");              \
                     for (int d_ = 0; d_ < 4; ++d_) for (int r = 0; r < 16; ++r) o[d_][r] *= al_l[crow(r, hi)]; } } while (0)
#define KBASE(t) ((j_lo + (t)) * KVBLK)
#define ACT(t) (KBASE(t) <= qlo + QBLK - 1 && KBASE(t) + KVBLK - 1 >= qlo - W + 1)
#define MASKT(P0_, P1_, t) do { const int kb_ = KBASE(t); if ((!SK || ACT(t)) && (kb_ + KVBLK - 1 > qlo || kb_ <= qlo + QBLK - 1 - W)) mask_tile(P0_, P1_, qm - kb_, (unsigned)W); } while (0)
    constexpr int NQL = F32 ? 16 : 8;
    constexpr bool SK = WSKIP && !F32;
#define SEAM_K0() do { VMWN(NQL); if constexpr (F32) { SWRITE_KF(0); SBAR(); SLOAD_F((const float*)nxt.V, kbn); } else { SWRITE_HK(0); } SBAR(); } while (0)
    f32x16 pA0, pA1, pB0, pB1; float mnA, mnB, alA, alB; bf16x8 pa0, pa1, pa2, pa3;
    if constexpr (F32) { VMW(); SWRITE_VF(0); SBAR(); } else { SWRITE_HV(0); SBAR(); }
    if (NT > 1) { if constexpr (F32) SLOAD_F((const float*)Kh, KBASE(1)); else SLOAD_H(Kh, Vh, KBASE(1)); }
    SBAR(); qkt<0, SK>(pA0, pA1, K_lds, r32, hi, S.qr, ACT(0));
    if constexpr (F32) { if (NT > 1) { VMW(); SWRITE_KF(1); SBAR(); SLOAD_F((const float*)Vh, KBASE(1)); } }
    MASKT(pA0, pA1, 0); partialSM(pA0, pA1, m_reg, mnA, alA);
    if (NT > 1) { VMW(); if constexpr (F32) { SWRITE_VF(1); SBAR(); if (NT > 2) SLOAD_F((const float*)Kh, KBASE(2)); } else SWRITE_H(1); }
    __syncthreads();
#define HALF_STEP(PX0, PX1, mnX, alX, PY0, PY1, alY, t, KB, VB, SB) do {                                                      \
        SBAR(); qkt<KB, SK>(PX0, PX1, K_lds, r32, hi, S.qr, ACT(t));                                             \
        finishSM(PY0, PY1, alY, l_reg, pa0, pa1, pa2, pa3); SBAR();                                                           \
        if ((t) + 1 < NT) { if constexpr (F32) { VMW(); SWRITE_KF(SB); SBAR(); SLOAD_F((const float*)Vh, KBASE((t) + 1)); }  \
                            else { SLOAD_H(Kh, Vh, KBASE((t) + 1)); } SBAR(); }                                               \
        pv_tile<VB, SK>(o, vb0, pa0, pa1, pa2, pa3, ACT((t) - 1)); MASKT(PX0, PX1, (t)); partialSM(PX0, PX1, m_reg, mnX, alX);                                        \
        __syncthreads();                                                                                                      \
        if ((t) + 1 < NT) { VMW(); if constexpr (F32) { SWRITE_VF(SB); SBAR(); if ((t) + 2 < NT) SLOAD_F((const float*)Kh, KBASE((t) + 2)); } \
                            else { SWRITE_H(SB); } }                                                                          \
        RESC(alX); __syncthreads(); } while (0)
    for (int t = 1; t + 1 < NT; t += 2) {
        HALF_STEP(pB0, pB1, mnB, alB, pA0, pA1, alA, t, 1, 0, 0);
        HALF_STEP(pA0, pA1, mnA, alA, pB0, pB1, alB, t + 1, 0, 1, 1);
    }
    const bool even = (NT & 1) == 0;
    if (even) { SBAR(); qkt<1, SK>(pB0, pB1, K_lds, r32, hi, S.qr, ACT(NT - 1)); SBAR(); }
#define QROW(e) (nxt.Q + (size_t)(wid * QBLK + r32) * D + ((e) >> 1) * 16 + hi * 8 + ((e) & 1) * 4)
    if constexpr (F32) { SLOAD_F((const float*)nxt.K, kbn); SBAR();
#pragma unroll
        for (int e = 0; e < 8; ++e) S.tq[e] = *(const f32x4*)QROW(e); }
    else { SLOAD_H(nxt.K, nxt.V, kbn); SBAR();
#pragma unroll
        for (int d0 = 0; d0 < 8; ++d0) S.qr[d0] = load8<TIn>(nxt.Q + (size_t)(wid * QBLK + r32) * LDQ + d0 * 16 + hi * 8); }
    SBAR();
    finishSM(pA0, pA1, alA, l_reg, pa0, pa1, pa2, pa3); SBAR();
    if constexpr (F32) {
#pragma unroll
        for (int e = 8; e < 16; ++e) S.tq[e] = *(const f32x4*)QROW(e); SBAR(); }
#undef QROW
    pv_tile<0, SK>(o, vb0, pa0, pa1, pa2, pa3, ACT(even ? NT - 2 : NT - 1));
    if (even) { MASKT(pB0, pB1, NT - 1); partialSM(pB0, pB1, m_reg, mnB, alB); __syncthreads(); RESC(alB);
        finishSM(pB0, pB1, alB, l_reg, pa0, pa1, pa2, pa3); SBAR(); pv_tile<1, SK>(o, vb0, pa0, pa1, pa2, pa3, ACT(NT - 1)); }
    SBAR(); SEAM_K0();
    if (hi == 0) li_l[r32] = l_reg; asm volatile("s_waitcnt lgkmcnt(0)" ::: "memory");
    float rli[16];
#pragma unroll
    for (int r = 0; r < 16; ++r) rli[r] = __builtin_amdgcn_rcpf(li_l[crow(r, hi)]);
    {
        unsigned* park = (unsigned*)(lds + ATT_LDS_BYTES) + (tid >> 1);
        TOut* op = cur.O + (size_t)(wid * QBLK + 4 * hi) * LDO + r32;
        const int md = cur.mode; const bool ev = (r32 & 1) == 0;
#pragma unroll
        for (int r = 0; r < 16; ++r) {
#pragma unroll
            for (int d0 = 0; d0 < 4; ++d0) { const float v = o[d0][r] * rli[r]; const float vn = swz<1>(v);
                if (md == 0) { if (ev) park[(r * 4 + d0) * 256] = cvtpk(v, vn); }
                else if (ev) { const unsigned w = park[(r * 4 + d0) * 256];
                    *(unsigned*)(op + d0 * 32) = cvtpk(__uint_as_float(w << 16) - lam * v, __uint_as_float(w & 0xffff0000u) - lam * vn); } }
            op += ((r & 3) == 3 ? 5 : 1) * LDO; asm volatile("" : "+v"(op));
        }
    }
    if constexpr (F32) {
#pragma unroll
        for (int d0 = 0; d0 < 8; ++d0) S.qr[d0] = pack8(S.tq[2 * d0], S.tq[2 * d0 + 1]); }
    __syncthreads();
#undef RESC
#undef KBASE
#undef ACT
#undef MASKT
#undef SEAM_K0
#undef HALF_STEP
}
#undef ROW
#undef VMW
#undef VMWN
#undef SLOAD_H
#undef SWRITE_HK
#undef SWRITE_HV
#undef SWRITE_H
#undef SLOAD_F
#undef SWRITE_KF
#undef SWRITE_VF
typedef BlockRef<bf16_t, bf16_t> BR;
__device__ __forceinline__ BR make_blk(int idx, int w, int G, const bf16_t* z, const bf16_t* kv, bf16_t* cat) {
    const int L = w + G * (idx >> 2);
    int b, h, e, y;
    if (G == 256) { const int xcd = w & 7, jx = w >> 3, bh = (idx >> 2) * 8 + xcd; b = bh >> 2; h = bh & 3; e = jx >> 4; y = jx & 15; }
    else { const int combo = L >> 4; y = L & 15; b = combo >> 3; h = (combo >> 1) & 3; e = combo & 1; }
    const int sub = idx & 3, qb = (sub >> 1) ? y : 31 - y, c = sub & 1;
    BR r;
    r.Q = z + (size_t)(b * SEQ + qb * QB) * LDQ + h * 256 + c * 128;
    r.K = kv + (size_t)(b * SEQ) * LDKV + h * 256 + c * 128;
    r.V = kv + (size_t)(b * SEQ) * LDKV + 1024 + h * 256 + e * 128;
    r.O = cat + (size_t)(b * SEQ + qb * QB) * LDO + h * 256 + e * 128;
    r.P0 = qb * QB; r.mode = c;
    return r;
}
__device__ __forceinline__ void attn_phase(char* lds, const bf16_t* z, const bf16_t* kv, bf16_t* cat, float lam, int w, int G) {
    int nitems = 0; for (int L = w; L < 1024; L += G) ++nitems;
    const int nblk = nitems * 4; if (nblk == 0) return;
    BR cur = make_blk(0, w, G, z, kv, cat);
    Seam<bf16_t> S;
    causal_swa_prime<bf16_t, bf16_t>(cur, SEQ, lds, S);
    for (int idx = 0; idx < nblk; ++idx) {
        const BR nxt = (idx + 1 < nblk) ? make_blk(idx + 1, w, G, z, kv, cat) : cur;
        causal_swa_block<bf16_t, bf16_t>(cur, nxt, SEQ, SEQ, lds, S, lam);
        cur = nxt;
    }
}
}

__device__ __forceinline__ void norm_rows(const float* src, const float* g, bf16_t* dst, int nrows, int gw, int NGW, int lane) {
    f32x4 gv[4];
#pragma unroll
    for (int j = 0; j < 4; ++j) gv[j] = ((const f32x4*)g)[lane + 64 * j];
    for (int m = gw; m < nrows; m += NGW) {
        const f32x4* xr = (const f32x4*)(src + (size_t)m * DM) + lane;
        f32x4 v[4]; float s = 0.f;
#pragma unroll
        for (int j = 0; j < 4; ++j) { v[j] = xr[64 * j]; s += (v[j].x * v[j].x + v[j].y * v[j].y) + (v[j].z * v[j].z + v[j].w * v[j].w); }
        const float rstd = __builtin_amdgcn_rsqf(wave_sum(s) * (1.f / DM) + 1e-6f);
        u32x2* o8 = (u32x2*)(dst + (size_t)m * DM) + lane;
#pragma unroll
        for (int j = 0; j < 4; ++j) { const f32x4 y = v[j] * rstd * gv[j]; u32x2 w; w.x = cvt_pk_bf16(y.x, y.y); w.y = cvt_pk_bf16(y.z, y.w); o8[64 * j] = w; }
    }
}
__device__ __forceinline__ void hb_rows(const float* src, bf16_t* dst, float* ssq, int nrows, int gw, int NGW, int lane) {
    for (int m = gw; m < nrows; m += NGW) {
        const f32x4* xr = (const f32x4*)(src + (size_t)m * DM) + lane;
        f32x4 v[4]; float s = 0.f;
#pragma unroll
        for (int j = 0; j < 4; ++j) { v[j] = xr[64 * j]; s += (v[j].x * v[j].x + v[j].y * v[j].y) + (v[j].z * v[j].z + v[j].w * v[j].w); }
        s = wave_sum(s);
        u32x2* o8 = (u32x2*)(dst + (size_t)m * DM) + lane;
#pragma unroll
        for (int j = 0; j < 4; ++j) { u32x2 w; w.x = cvt_pk_bf16(v[j].x, v[j].y); w.y = cvt_pk_bf16(v[j].z, v[j].w); o8[64 * j] = w; }
        if (lane == 0) *(f32x4*)(ssq + (size_t)m * 4) = (f32x4){s, 0.f, 0.f, 0.f};
    }
}
__device__ __forceinline__ void final_rows(const bf16_t* h, float* out, const float* g, int gw, int NGW, int lane) {
    f32x4 gv[4];
#pragma unroll
    for (int j = 0; j < 4; ++j) gv[j] = ((const f32x4*)g)[lane + 64 * j];
    for (int m = gw; m < MTOK; m += NGW) {
        const u32x2* xr = (const u32x2*)(h + (size_t)m * DM) + lane;
        f32x4 v[4]; float s = 0.f;
#pragma unroll
        for (int j = 0; j < 4; ++j) { const u32x2 q = xr[64 * j]; v[j] = (f32x4){bf_lo(q.x), bf_hi(q.x), bf_lo(q.y), bf_hi(q.y)}; s += (v[j].x * v[j].x + v[j].y * v[j].y) + (v[j].z * v[j].z + v[j].w * v[j].w); }
        const float rstd = __builtin_amdgcn_rsqf(wave_sum(s) * (1.f / DM) + 1e-6f);
        f32x4* orow = (f32x4*)(out + (size_t)m * DM) + lane;
#pragma unroll
        for (int j = 0; j < 4; ++j) orow[64 * j] = v[j] * rstd * gv[j];
    }
}
__device__ __forceinline__ void transpose_item(const float* W, int K, int N, bf16_t* WT, int ldw, int kb, int n0, int drow0, const float* gk, LAS float* scr, int lane) {
    const int k0 = 64 * kb;
    f32x4 v[8];
#pragma unroll
    for (int i = 0; i < 8; ++i) v[i] = *(const f32x4*)(W + (size_t)(k0 + 8 * i + (lane >> 3)) * N + n0 + (lane & 7) * 4);
#pragma unroll
    for (int i = 0; i < 8; ++i) { LAS float* q = scr + (8 * i + (lane >> 3)) * 33 + (lane & 7) * 4; q[0] = v[i][0]; q[1] = v[i][1]; q[2] = v[i][2]; q[3] = v[i][3]; }
    asm volatile("s_waitcnt lgkmcnt(0)" ::: "memory");
    const int c = lane & 7;
    f32x4 g0 = {1.f, 1.f, 1.f, 1.f}, g1 = g0;
    if (gk) { g0 = *(const f32x4*)(gk + k0 + 8 * c); g1 = *(const f32x4*)(gk + k0 + 8 * c + 4); }
#pragma unroll
    for (int j = 0; j < 4; ++j) { const int n = (lane >> 3) + 8 * j; const LAS float* s = scr + (8 * c) * 33 + n;
        u32x4 o; o.x = cvt_pk_bf16(s[0 * 33] * g0[0], s[1 * 33] * g0[1]); o.y = cvt_pk_bf16(s[2 * 33] * g0[2], s[3 * 33] * g0[3]); o.z = cvt_pk_bf16(s[4 * 33] * g1[0], s[5 * 33] * g1[1]); o.w = cvt_pk_bf16(s[6 * 33] * g1[2], s[7 * 33] * g1[3]);
        *(u32x4*)(WT + (size_t)(drow0 + n) * ldw + k0 + 8 * c) = o; }
    asm volatile("s_waitcnt lgkmcnt(0)" ::: "memory");
}
__device__ __forceinline__ void conv_matrix(const float* W, int K, int N, bf16_t* WT, int ldw, int mode  , const float* gk, LAS float* scr, int gw, int NGW, int lane) {
    const int nblk = N / 32, nitems = (K / 64) * nblk;
    for (int it = gw; it < nitems; it += NGW) {
        const int kb = it / nblk, n0 = (it % nblk) * 32;
        const int drow0 = mode == 0 ? n0 : 256 * (n0 >> 7) + (n0 & 127) + (mode == 2 ? 128 : 0);
        transpose_item(W, K, N, WT, ldw, kb, n0, drow0, gk, scr, lane);
    }
}
__device__ __forceinline__ void pool_phase(const bf16_t* z, bf16_t* pooled, int ldp, int gw, int NGW, int lane) {
    for (int it = gw; it < (MTOK / 64) * 2; it += NGW) {
        const int half = it & 1, r0 = (it >> 1) * 64, ch = half * 512 + lane * 8, w = 2 << (ch >> 8), t0 = r0 & (SEQ - 1);
        const bf16_t* zp = z + (size_t)r0 * INW + ch;
        float acc[8];
#pragma unroll
        for (int e = 0; e < 8; ++e) acc[e] = 0.f;
        for (int j = 1; j <= 16; ++j) {
            if (j <= w && t0 - j >= 0) { const u32x4 q = *(const u32x4*)(zp - (size_t)j * INW);
                acc[0] += bf_lo(q.x); acc[1] += bf_hi(q.x); acc[2] += bf_lo(q.y); acc[3] += bf_hi(q.y); acc[4] += bf_lo(q.z); acc[5] += bf_hi(q.z); acc[6] += bf_lo(q.w); acc[7] += bf_hi(q.w); }
        }
        for (int t = 0; t < 64; ++t) {
            const u32x4 q = *(const u32x4*)(zp + (size_t)t * INW);
            float u[8] = {bf_lo(q.x), bf_hi(q.x), bf_lo(q.y), bf_hi(q.y), bf_lo(q.z), bf_hi(q.z), bf_lo(q.w), bf_hi(q.w)};
            const int tt = t0 + t;
            unsigned zz; asm volatile("v_mov_b32 %0, 0" : "=v"(zz)); u32x4 o4 = {zz, zz, zz, zz};
            if (tt - w >= 0) o4 = *(const u32x4*)(zp + (ptrdiff_t)(t - w) * INW);
            const float old[8] = {bf_lo(o4.x), bf_hi(o4.x), bf_lo(o4.y), bf_hi(o4.y), bf_lo(o4.z), bf_hi(o4.z), bf_lo(o4.w), bf_hi(o4.w)};
            const float inv = 1.0f / (float)(tt + 1 < w ? tt + 1 : w);
            float r[8];
#pragma unroll
            for (int e = 0; e < 8; ++e) { acc[e] += u[e] - old[e]; r[e] = acc[e] * inv - u[e]; }
            u32x4 o; o.x = cvt_pk_bf16(r[0], r[1]); o.y = cvt_pk_bf16(r[2], r[3]); o.z = cvt_pk_bf16(r[4], r[5]); o.w = cvt_pk_bf16(r[6], r[7]);
            *(u32x4*)(pooled + (size_t)(r0 + t) * ldp + ch) = o;
        }
    }
}
__device__ __forceinline__ void subln_phase(bf16_t* cat, const float* gsub, float omli, int gw, int NGW, int lane) {
    float gv[16];
#pragma unroll
    for (int e = 0; e < 16; ++e) gv[e] = gsub[(lane & 15) * 16 + e] * omli;
    for (int m = gw; m < MTOK; m += NGW) {
        u32x4* p = (u32x4*)(cat + (size_t)m * LDCAT + lane * 16);
        const u32x4 q0 = p[0], q1 = p[1];
        float v[16] = {bf_lo(q0.x), bf_hi(q0.x), bf_lo(q0.y), bf_hi(q0.y), bf_lo(q0.z), bf_hi(q0.z), bf_lo(q0.w), bf_hi(q0.w),
                       bf_lo(q1.x), bf_hi(q1.x), bf_lo(q1.y), bf_hi(q1.y), bf_lo(q1.z), bf_hi(q1.z), bf_lo(q1.w), bf_hi(q1.w)};
        float s = 0.f;
#pragma unroll
        for (int e = 0; e < 16; ++e) s += v[e] * v[e];
        s += swz<1>(s); s += swz<2>(s); s += swz<4>(s); s += swz<8>(s);
        const float rstd = __builtin_amdgcn_rsqf(s * (1.f / 256.f) + 1e-5f);
#pragma unroll
        for (int e = 0; e < 16; ++e) v[e] = v[e] * rstd * gv[e];
        u32x4 o0, o1;
        o0.x = cvt_pk_bf16(v[0], v[1]); o0.y = cvt_pk_bf16(v[2], v[3]); o0.z = cvt_pk_bf16(v[4], v[5]); o0.w = cvt_pk_bf16(v[6], v[7]);
        o1.x = cvt_pk_bf16(v[8], v[9]); o1.y = cvt_pk_bf16(v[10], v[11]); o1.z = cvt_pk_bf16(v[12], v[13]); o1.w = cvt_pk_bf16(v[14], v[15]);
        p[0] = o0; p[1] = o1;
    }
}
__device__ __forceinline__ void rope_entry(float* cosT, float* sinT, float invf, int idx) {
    {
        const int pos = idx >> 4;
        const float ang = (float)pos * invf;
        double t = (double)ang * 0.15915494309189533577;
        t -= rint(t);
        const double kq = rint(t * 4.0);
        const double y = (t - kq * 0.25) * 6.283185307179586476925;
        const double y2 = y * y;
        double sn = y * (1.0 + y2 * (-1.0 / 6 + y2 * (1.0 / 120 + y2 * (-1.0 / 5040 + y2 * (1.0 / 362880 + y2 * (-1.0 / 39916800 + y2 * (1.0 / 6227020800.0)))))));
        double cs = 1.0 + y2 * (-0.5 + y2 * (1.0 / 24 + y2 * (-1.0 / 720 + y2 * (1.0 / 40320 + y2 * (-1.0 / 3628800 + y2 * (1.0 / 479001600.0 + y2 * (-1.0 / 87178291200.0)))))));
        const int kk = ((int)kq) & 3;
        double c, s;
        if (kk == 0) { c = cs; s = sn; } else if (kk == 1) { c = -sn; s = cs; } else if (kk == 2) { c = -cs; s = -sn; } else { c = sn; s = -cs; }
        cosT[idx] = (float)c; sinT[idx] = (float)s;
    }
}
__device__ __forceinline__ void fold_pool(const float* wp  , const float* sc  , const float* wout  , bf16_t* WT  , int gtid, int ngt) {
    for (int it = gtid; it < 1024 * 128; it += ngt) {
        const int n = (it & 63) | ((it >> 13) << 6), kc = (it >> 6) & 127, g = kc >> 5, kk0 = (kc & 31) * 8;
        const float* wpr = wp + (size_t)g * 65536 + (size_t)kk0 * 256;
        float acc[8];
#pragma unroll
        for (int i = 0; i < 8; ++i) acc[i] = 0.f;
        for (int e = 0; e < 256; ++e) {
            const float wv = wout[(size_t)(g * 256 + e) * DM + n] * sc[g * 256 + e];
#pragma unroll
            for (int i = 0; i < 8; ++i) acc[i] += wpr[i * 256 + e] * wv;
        }
        u32x4 o; o.x = cvt_pk_bf16(acc[0], acc[1]); o.y = cvt_pk_bf16(acc[2], acc[3]); o.z = cvt_pk_bf16(acc[4], acc[5]); o.w = cvt_pk_bf16(acc[6], acc[7]);
        *(u32x4*)(WT + (size_t)n * LDCAT + kc * 8) = o;
    }
}
#define XB_TMO      128
#define XB_XCNT(j)  (256  + 64 * (j))
#define XB_XSUB(j)  (1280 + 64 * (j))
#define XB_XGEN(j)  (2304 + 64 * (j))
#define XB_TOP      3328
#define XB_TOPGEN   3392
#define XCD_BAR_WORDS 3456
#define XB_SPIN_CAP (1u << 18)

__device__ __forceinline__ unsigned xb_ld(unsigned* p)              { return __hip_atomic_load(p, __ATOMIC_RELAXED, __HIP_MEMORY_SCOPE_AGENT); }
__device__ __forceinline__ unsigned xb_add(unsigned* p, unsigned v) { return __hip_atomic_fetch_add(p, v, __ATOMIC_RELAXED, __HIP_MEMORY_SCOPE_AGENT); }
__device__ __forceinline__ unsigned xb_xcc_id() { return (unsigned)__builtin_amdgcn_s_getreg((3 << 11) | 20) & 0xFu; }
#define XB_SPIN(cond, bar) do { unsigned _sp = 0; while (cond) { __builtin_amdgcn_s_sleep(1); \
    if ((++_sp & 255u) == 0u) { if (xb_ld(&(bar)[XB_TMO])) break; if (_sp > XB_SPIN_CAP) { atomicAdd(&(bar)[XB_TMO], 1u); break; } } } } while (0)

struct XcdBarrier {
    unsigned* bar; unsigned x;
    volatile LAS unsigned* st;
};

__device__ __forceinline__ XcdBarrier xcd_barrier_post(unsigned* bar, volatile LAS unsigned* st) {
    XcdBarrier b; b.bar = bar; b.x = xb_xcc_id(); b.st = st;
    if (threadIdx.x == 0) (void)xb_add(&bar[XB_XCNT(b.x)], 1u);
    return b;
}
__device__ __forceinline__ void xcd_barrier_complete(unsigned* bar, unsigned x, unsigned& nloc, unsigned& nx) {
    const unsigned G = gridDim.x * gridDim.y * gridDim.z;
    unsigned sum, cnt, mine, sp = 0u;
    for (;;) {
        sum = 0u; cnt = 0u; mine = 0u;
#pragma unroll
        for (unsigned j = 0; j < 16; ++j) { const unsigned c = xb_ld(&bar[XB_XCNT(j)]); sum += c; cnt += (c > 0u) ? 1u : 0u; mine = (j == x) ? c : mine; }
        if (sum == G) break;
        __builtin_amdgcn_s_sleep(1);
        if ((++sp & 255u) == 0u) { if (xb_ld(&bar[XB_TMO])) break; if (sp > XB_SPIN_CAP) { atomicAdd(&bar[XB_TMO], 1u); break; } }
    }
    nloc = mine > 0u ? mine : 1u; nx = cnt > 0u ? cnt : 1u;
}

__device__ __forceinline__ void xcd_barrier(const XcdBarrier& b) {
    asm volatile("s_waitcnt vmcnt(0)" ::: "memory");
    __syncthreads();
    if (threadIdx.x == 0) {
        unsigned* bar = b.bar;
        __builtin_amdgcn_s_waitcnt(0);
        unsigned nloc = b.st[0], nx = b.st[1];
        if (nloc == 0u) { xcd_barrier_complete(bar, b.x, nloc, nx); b.st[0] = nloc; b.st[1] = nx; }
        const unsigned old = xb_add(&bar[XB_XSUB(b.x)], 1u);
        const unsigned gen = old / nloc;
        if (old + 1u == (gen + 1u) * nloc) {
            __builtin_amdgcn_fence(__ATOMIC_RELEASE, "agent");
            asm volatile("s_waitcnt vmcnt(0)" ::: "memory");
            const unsigned og = xb_add(&bar[XB_TOP], 1u);
            const unsigned tg = og / nx;
            if (og + 1u == (tg + 1u) * nx) xb_add(&bar[XB_TOPGEN], 1u);
            else XB_SPIN(xb_ld(&bar[XB_TOPGEN]) == tg, bar);
            __builtin_amdgcn_fence(__ATOMIC_ACQUIRE, "agent");
            xb_add(&bar[XB_XGEN(b.x)], 1u);
            asm volatile("s_waitcnt vmcnt(0)" ::: "memory");
        } else {
            XB_SPIN(xb_ld(&bar[XB_XGEN(b.x)]) == gen, bar);
            __builtin_amdgcn_fence(__ATOMIC_ACQUIRE, "agent");
            asm volatile("s_waitcnt vmcnt(0)" ::: "memory");
        }
    }
    __syncthreads();
}
struct Args { const float* in[21]; float* out; unsigned char* ws; float invf[16]; float lam_init[2]; int j_lo, j_hi, coop, pad; };
constexpr int NJOBS = 43;
__host__ __device__ inline void job_info(int j, int& layer, int& s, bool& sync) {
    if (j < 11) { layer = 0; s = j; s += (s >= 9); }
    else if (j < 21) { layer = 1; s = j - 11 + 1; s += (s >= 9); }
    else if (j == 21) { layer = 1; s = 15; }
    else if (j < 42) { layer = 2 + (j - 22) / 10; s = (j - 22) % 10 + 1; s += (s >= 9); }
    else { layer = 3; s = 16; }
    sync = !(s == 1 || s == 2 || s == 4 || s == 6 || s == 16 || (s == 5 && layer < 2));
}
__global__ void __launch_bounds__(NTHREADS, 2) fwd_kernel(Args a_) {
#if defined(__HIP_DEVICE_COMPILE__)
    extern __shared__ __attribute__((aligned(16))) unsigned char lds_raw[];
    cg::grid_group grid = cg::this_grid();
    LAS unsigned char* lds = (LAS unsigned char*)lds_raw;
    const int j_lo = a_.j_lo, j_hi = a_.j_hi, coop = a_.coop;
    volatile LAS unsigned* misc = (volatile LAS unsigned*)(lds + LDS_MISC);
    if (threadIdx.x < 16) misc[threadIdx.x] = 0u;
    __syncthreads();
    if (coop) {
        unsigned* bar0 = (unsigned*)(a_.ws + WS_CTL);
        if (blockIdx.x == 0) { for (int u = threadIdx.x; u < XCD_BAR_WORDS; u += NTHREADS) __hip_atomic_store(bar0 + u, 0u, __ATOMIC_RELAXED, __HIP_MEMORY_SCOPE_AGENT);
            __builtin_amdgcn_fence(__ATOMIC_RELEASE, "agent"); asm volatile("s_waitcnt vmcnt(0)" ::: "memory"); }
        grid.sync();
        (void)xcd_barrier_post(bar0, misc);
    }
    if (j_lo == 0) { float* cT = (float*)(a_.ws + WS_ROPE);
        for (int idx = blockIdx.x * NTHREADS + threadIdx.x; idx < SEQ * 16; idx += gridDim.x * NTHREADS) rope_entry(cT, cT + SEQ * 16, a_.invf[idx & 15], idx); }
    for (int j = j_lo; j < j_hi; ++j) {
        int layer, s; bool sync; job_info(j, layer, s, sync);
        typedef const __attribute__((address_space(4))) Args* ArgP;
        ArgP ap = (ArgP)__builtin_amdgcn_kernarg_segment_ptr();
        asm volatile("" : "+s"(ap));
#define AIN(k) (ap->in[k])
        int tid_ = threadIdx.x; asm volatile("" : "+v"(tid_));
        const int tid = tid_, lane = tid & 63, wave = __builtin_amdgcn_readfirstlane(tid >> 6);
        int G_ = gridDim.x, wg_ = blockIdx.x; asm volatile("" : "+s"(G_), "+s"(wg_));
        const int G = G_, wg = wg_, gw = wg * NWAVES + wave, NGW = G * NWAVES;
        unsigned char* ws = ap->ws;
        bf16_t* const CAT = (bf16_t*)(ws + WS_CAT); bf16_t* const Z = (bf16_t*)(ws + WS_Z); bf16_t* const ACT = (bf16_t*)(ws + WS_CAT);
        bf16_t* const KV = (bf16_t*)(ws + WS_KV); bf16_t* const POOLED = KV; bf16_t* const HB = (bf16_t*)(ws + WS_P); bf16_t* const P = (bf16_t*)ap->out;     float* const SSQ = (float*)(ws + WS_SSQ);
        const bool do_prep = (s == 0) || (s == 6 && layer < 3); const int pl = (s == 0) ? layer : layer + 1;
        unsigned char* wsw = ws - (((do_prep ? pl : layer) & 1) ? (WS_WIN - WS_OSCR) : 0);
        bf16_t* const WIN = (bf16_t*)(wsw + WS_WIN); bf16_t* const WOUT = (bf16_t*)(wsw + WS_WOUT); bf16_t* const WGU = (bf16_t*)(wsw + WS_WGU); bf16_t* const WDN = (bf16_t*)(wsw + WS_WDN);
        bf16_t* const WMKV = (bf16_t*)(wsw + WS_WMKV); bf16_t* const WPOOL = (bf16_t*)(ws + WS_WPOOL); bf16_t* const WKV = (bf16_t*)(ws + WS_WKV);
        bf16_t* const MEMN = (bf16_t*)(ws + WS_MEMN); bf16_t* const KM = (bf16_t*)(ws + WS_KM); bf16_t* const VT = (bf16_t*)(ws + WS_VT);
        float* const COST = (float*)(ws + WS_ROPE); float* const SINT = COST + SEQ * 16;
        const float* x = AIN(0); float* out = ap->out;
        bool is_gemm = false;
        pg8::GemmDesc d;
        d.A = nullptr; d.B = nullptr; d.lda = 0; d.ldb = 0; d.K = 0; d.rev = 0; d.sched = 0; d.nM = 0; d.nN = 0; d.cid = wg; d.G = G; d.a_h = 0; d.b_b = 0; d.b_h = 0; d.epi = pg8::EPI_BF16;
        d.O = nullptr; d.ldc = 0; d.col_off = 0; d.col_h = 0; d.rope_limit = 0; d.cosT = COST; d.sinT = SINT; d.colscale = nullptr; d.base = nullptr; d.hb = nullptr; d.ssq_out = nullptr; d.ssq_in = nullptr;
        if (do_prep) {
            LAS float* scr = (LAS float*)(lds + wave * 16384);
            conv_matrix(AIN(2) + (size_t)pl * DM * INW, DM, INW, WIN, DM, 0, AIN(4) + pl * DM, scr, gw, NGW, lane);
            if (pl < 2) { conv_matrix(AIN(3) + (size_t)pl * INW * DM + (size_t)DM * DM, DM, DM, WOUT + DM, LDCAT, 0, nullptr, scr, (gw + NGW / 2) % NGW, NGW, lane);
                fold_pool(AIN(11) + (size_t)pl * 4 * 65536, AIN(12) + pl * DM, AIN(3) + (size_t)pl * INW * DM, WOUT, wg * NTHREADS + tid, G * NTHREADS); }
            else conv_matrix(AIN(3) + (size_t)pl * INW * DM, INW, DM, WOUT, LDCAT, 0, nullptr, scr, (gw + NGW / 2) % NGW, NGW, lane);
            conv_matrix(AIN(6) + (size_t)pl * DM * DFF, DM, DFF, WGU, DM, 1, AIN(5) + pl * DM, scr, gw, NGW, lane);
            conv_matrix(AIN(7) + (size_t)pl * DM * DFF, DM, DFF, WGU, DM, 2, AIN(5) + pl * DM, scr, (gw + NGW / 2) % NGW, NGW, lane);
            conv_matrix(AIN(8) + (size_t)pl * DFF * DM, DFF, DM, WDN, DFF, 0, nullptr, scr, gw, NGW, lane);
            conv_matrix(AIN(10) + (size_t)pl * DM * INW, DM, INW, WMKV, DM, 0, nullptr, scr, (gw + NGW / 2) % NGW, NGW, lane);
            norm_rows(AIN(1), AIN(9) + pl * DM, MEMN, MROWS, gw, NGW, lane);
            if (pl == 0) {
                conv_matrix(AIN(14), DM, INW, WKV, DM, 0, AIN(13), scr, gw, NGW, lane);
                hb_rows(x, HB, SSQ, MTOK, gw, NGW, lane);
            }
        }
        if (s == 0) {
        } else if (s == 1) {
            is_gemm = true; d.A = (const char*)HB; d.lda = DM; d.B = (const char*)WIN; d.ldb = DM; d.K = DM; d.nM = MTOK / 256; d.nN = INW / 256;
            d.O = Z; d.ldc = INW; d.rev = 1; d.rope_limit = layer >= 2 ? 1024 : 0; d.ssq_in = SSQ + (size_t)(2 * layer) * MTOK * 4;
        } else if (s == 2) {
            is_gemm = true; d.A = (const char*)MEMN; d.lda = DM; d.B = (const char*)WMKV; d.ldb = DM; d.K = DM; d.nM = MROWS / 256; d.nN = 4; d.O = KM; d.ldc = DM;
        } else if (s == 3) {
            is_gemm = true; d.A = (const char*)(WMKV + (size_t)DM * DM); d.lda = DM; d.B = (const char*)MEMN; d.ldb = DM; d.K = DM; d.nM = 4; d.nN = MROWS / 256; d.cid = (wg + G - 32) % G; d.O = VT; d.ldc = MROWS;
        } else if (s == 4) {
            if (layer < 2) pool_phase(Z, CAT, LDCAT, gw, NGW, lane);
            else {
                const int jj = layer - 2;
                const float d1 = wave_sum(AIN(15)[jj * 128 + lane] * AIN(16)[jj * 128 + lane] + AIN(15)[jj * 128 + 64 + lane] * AIN(16)[jj * 128 + 64 + lane]);
                const float d2 = wave_sum(AIN(17)[jj * 128 + lane] * AIN(18)[jj * 128 + lane] + AIN(17)[jj * 128 + 64 + lane] * AIN(18)[jj * 128 + 64 + lane]);
                const float lam = __builtin_amdgcn_exp2f(d1 * 1.4426950408889634f) - __builtin_amdgcn_exp2f(d2 * 1.4426950408889634f) + ap->lam_init[jj];
                att::attn_phase((char*)lds_raw, Z, KV, CAT, lam, wg, G);
            }
        } else if (s == 5) {
            is_gemm = true; d.A = (const char*)(Z + 1024); d.lda = INW; d.a_h = 512; d.B = (const char*)KM; d.ldb = DM; d.b_b = (long)NMEM * DM * 2; d.b_h = 512; d.K = 256; d.sched = 1;
            d.epi = pg8::EPI_SOFTMAX; d.O = P; d.ldc = DM; d.col_h = 256;
        } else if (s == 6) {
            if (layer < 2) { }
            else subln_phase(CAT, AIN(19) + (layer - 2) * 256, 1.0f - ap->lam_init[layer - 2], gw, NGW, lane);
        } else if (s == 7) {
            is_gemm = true; d.A = (const char*)P; d.lda = DM; d.a_h = 512; d.B = (const char*)VT; d.ldb = MROWS; d.b_h = (long)256 * MROWS * 2; d.b_b = 512; d.K = 256; d.sched = 1;
            d.O = CAT; d.ldc = LDCAT; d.col_off = 1024; d.col_h = 256;
        } else if (s == 8) {
            is_gemm = true; d.A = (const char*)CAT; d.lda = LDCAT; d.B = (const char*)WOUT; d.ldb = LDCAT; d.K = INW; d.nM = MTOK / 256; d.nN = 4; d.epi = pg8::EPI_RES;
            d.ldc = DM; d.hb = HB; d.ssq_out = SSQ + (size_t)(1 + 2 * layer) * MTOK * 4;
        } else if (s == 10) {
            is_gemm = true; d.A = (const char*)HB; d.lda = DM; d.B = (const char*)WGU; d.ldb = DM; d.K = DM; d.nM = MTOK / 256; d.nN = 2 * DFF / 256; d.epi = pg8::EPI_SWIGLU; d.rev = 1;
            d.O = ACT; d.ldc = DFF; d.ssq_in = SSQ + (size_t)(1 + 2 * layer) * MTOK * 4;
        } else if (s == 11) {
            is_gemm = true; d.A = (const char*)ACT; d.lda = DFF; d.B = (const char*)WDN; d.ldb = DFF; d.K = DFF; d.nM = MTOK / 256; d.nN = 4; d.epi = pg8::EPI_RES;
            d.ldc = DM; d.hb = HB; d.ssq_out = SSQ + (size_t)(2 + 2 * layer) * MTOK * 4;
        } else if (s == 15) {
            is_gemm = true; d.A = (const char*)HB; d.lda = DM; d.B = (const char*)WKV; d.ldb = DM; d.K = DM; d.nM = MTOK / 256; d.nN = INW / 256; d.O = KV; d.ldc = INW; d.rev = 1; d.rope_limit = 1024; d.ssq_in = SSQ + (size_t)4 * MTOK * 4;
        } else {
            final_rows(HB, out, AIN(20), gw, NGW, lane);
        }
        if (is_gemm) {
            if (d.epi == pg8::EPI_BF16) pg8::gemm_phase<pg8::EPI_BF16>(lds, d);
            else if (d.epi == pg8::EPI_RES) pg8::gemm_phase<pg8::EPI_RES>(lds, d);
            else if (d.epi == pg8::EPI_SWIGLU) pg8::gemm_phase<pg8::EPI_SWIGLU>(lds, d);
            else pg8::gemm_phase<pg8::EPI_SOFTMAX>(lds, d);
        }
#undef AIN
        if (sync && j + 1 < j_hi) { XcdBarrier xb; xb.bar = (unsigned*)(ap->ws + WS_CTL); xb.x = xb_xcc_id(); xb.st = misc; xcd_barrier(xb); }
        else {
            if (s == 5) {
                asm volatile("s_waitcnt vmcnt(0)" ::: "memory"); __syncthreads();
                __builtin_amdgcn_fence(__ATOMIC_ACQUIRE, "agent"); asm volatile("s_waitcnt vmcnt(0)" ::: "memory");
            }
            __syncthreads();
        }
    }
#endif
}

#ifndef MK_COOP
#define MK_COOP 1
#endif
extern "C" void kernel_launch(void* const* d_in, const int* in_sizes, int n_in, void* d_out, int out_size, void* d_ws, size_t ws_size, hipStream_t stream) {
    static int grid = 0;
    if (grid == 0) {
        if (n_in != 21 || in_sizes[0] != MTOK * DM || out_size != MTOK * DM || ws_size < WS_END) { fprintf(stderr, "kernel_launch: unexpected shapes / workspace (n_in %d, ws %zu)\n", n_in, ws_size); grid = -1; return; }
        int dev = 0, cus = 0, per_cu = 0;
        (void)hipGetDevice(&dev); (void)hipDeviceGetAttribute(&cus, hipDeviceAttributeMultiprocessorCount, dev);
        if (hipFuncSetAttribute((const void*)fwd_kernel, hipFuncAttributeMaxDynamicSharedMemorySize, LDS_BYTES) != hipSuccess) { fprintf(stderr, "kernel_launch: hipFuncSetAttribute failed\n"); grid = -1; return; }
        if (hipOccupancyMaxActiveBlocksPerMultiprocessor(&per_cu, (const void*)fwd_kernel, NTHREADS, LDS_BYTES) != hipSuccess || per_cu < 1) { fprintf(stderr, "kernel_launch: occupancy query %d\n", per_cu); per_cu = 1; }
        (void)hipGetLastError();
        if (cus <= 0) cus = 256;
        grid = cus;
    }
    if (grid < 0) return;
    Args a{};
    for (int i = 0; i < 21; ++i) a.in[i] = (const float*)d_in[i];
    a.out = (float*)d_out; a.ws = (unsigned char*)d_ws;
    for (int i = 0; i < 16; ++i) a.invf[i] = (float)std::pow((double)500000.0, -(double)(2 * i) / 32.0);
    a.lam_init[0] = (float)(0.8 - 0.6 * std::exp(-0.3 * 2.0)); a.lam_init[1] = (float)(0.8 - 0.6 * std::exp(-0.3 * 3.0));
#if MK_COOP
    a.j_lo = 0; a.j_hi = NJOBS; a.coop = 1;
    void* params[] = {&a};
    hipError_t e = hipLaunchCooperativeKernel((const void*)fwd_kernel, dim3(grid), dim3(NTHREADS), params, LDS_BYTES, stream);
    if (e != hipSuccess) fprintf(stderr, "kernel_launch: cooperative launch failed: %s (grid %d)\n", hipGetErrorString(e), grid);
#else
    int j0 = 0;
    for (int j = 0; j < NJOBS; ++j) { int layer, s; bool sync; job_info(j, layer, s, sync);
        if (sync || j == NJOBS - 1) { a.j_lo = j0; a.j_hi = j + 1; hipLaunchKernelGGL(fwd_kernel, dim3(grid), dim3(NTHREADS), LDS_BYTES, stream, a); j0 = j + 1; } }
#endif
}
```
